# Optimizing an MI355X kernel written in HIP

```python
import math
import jax, jax.numpy as jnp
from jax import lax
import numpy as np

D_MODEL = 2048
BATCH = 1
SEQ = 16384
DEPTH = 2

N_MIXERS = 2
N_GDN_LAYERS = (DEPTH + 1) // 2
N_DSA_LAYERS = DEPTH // 2

GDN_QK_HEADS = 16
GDN_V_HEADS = 32
GDN_DK = 128
GDN_DV = 128
GDN_CONV = 4
GDN_CHUNK = 64
GDN_QK_W = GDN_QK_HEADS * GDN_DK
GDN_V_W = GDN_V_HEADS * GDN_DV
GDN_IN_W = 2 * GDN_QK_W + 2 * GDN_V_W + 2 * GDN_V_HEADS

DSA_HEADS = 16
DSA_KV_HEADS = 4
DSA_GROUP = DSA_HEADS // DSA_KV_HEADS
DSA_DH = 128
IDX_HEADS = 16
IDX_DIM = 128
TOPK_MAX = 256
Q_BLOCK = 128
DSA_IN_W = DSA_HEADS * DSA_DH + 2 * DSA_KV_HEADS * DSA_DH + IDX_HEADS * IDX_DIM + IDX_DIM + IDX_HEADS

N_BUCKETS = 32
MAX_DISTANCE = 128

D_FF = 5120
FFN_CONV = 3

PLE_DIM = 256

DN_ALPHA = (2.0 * DEPTH) ** 0.25
DN_BETA = (8.0 * DEPTH) ** -0.25
LN_EPS = 1e-5
RMS_EPS = 1e-6

kernel_name = "hybrid_gdn_dsa_convglu_deepnorm"


def layer_norm(x, g, b):
    xf = x.astype(jnp.float32)
    mu = jnp.mean(xf, -1, keepdims=True)
    var = jnp.mean(jnp.square(xf - mu), -1, keepdims=True)
    y = (xf - mu) * lax.rsqrt(var + LN_EPS) * g.astype(jnp.float32) + b.astype(jnp.float32)
    return y.astype(x.dtype)


def causal_dwconv(x, w):
    K = w.shape[0]
    L = x.shape[1]
    xp = jnp.pad(x, ((0, 0), (K - 1, 0), (0, 0)))
    return sum(xp[:, j:j + L] * w[j] for j in range(K))


def l2norm(x):
    return x * lax.rsqrt(jnp.sum(jnp.square(x), -1, keepdims=True) + RMS_EPS)


def gated_delta_rule(q, k, v, g, beta):
    B, L, H, dk = q.shape
    dv = v.shape[-1]
    C = GDN_CHUNK
    N = L // C

    def chunk(a):
        a = a.reshape(B, N, C, H, *a.shape[3:])
        return jnp.moveaxis(a, 3, 1)

    q, k, v, g, beta = chunk(q), chunk(k), chunk(v), chunk(g), chunk(beta)
    gc = jnp.cumsum(g, axis=-1)
    kb = k * beta[..., None]
    vb = v * beta[..., None]
    tri = jnp.tril(jnp.ones((C, C), dtype=bool))
    strict = jnp.tril(jnp.ones((C, C), dtype=bool), -1)
    diff = gc[..., :, None] - gc[..., None, :]
    decay = jnp.where(tri, jnp.exp(jnp.where(tri, diff, 0.0)), 0.0)
    lmat = jnp.where(strict, jnp.einsum('bhncd,bhnsd->bhncs', kb, k) * decay, 0.0)
    amat = lmat + jnp.eye(C, dtype=jnp.float32)
    rhs = jnp.concatenate([vb, kb * jnp.exp(gc)[..., None]], axis=-1)
    sol = lax.linalg.triangular_solve(amat, rhs, left_side=True, lower=True, unit_diagonal=True)
    u, w = sol[..., :dv], sol[..., dv:]
    qk = jnp.where(tri, jnp.einsum('bhncd,bhnsd->bhncs', q, k) * decay, 0.0)
    q_dec = q * jnp.exp(gc)[..., None]
    k_dec = k * jnp.exp(gc[..., -1:] - gc)[..., None]
    g_last = jnp.exp(gc[..., -1])

    def step(S, inp):
        u_n, w_n, qd_n, kd_n, qk_n, gl_n = inp
        v_new = u_n - jnp.einsum('bhck,bhkv->bhcv', w_n, S)
        o_n = jnp.einsum('bhck,bhkv->bhcv', qd_n, S) + jnp.einsum('bhcs,bhsv->bhcv', qk_n, v_new)
        S = S * gl_n[..., None, None] + jnp.einsum('bhck,bhcv->bhkv', kd_n, v_new)
        return S, o_n

    xs = tuple(jnp.moveaxis(a, 2, 0) for a in (u, w, q_dec, k_dec, qk, g_last))
    S0 = jnp.zeros((B, H, dk, dv), jnp.float32)
    _, o = lax.scan(step, S0, xs)
    o = jnp.transpose(o, (1, 0, 3, 2, 4))
    return o.reshape(B, L, H, dv)


def gdn_mixer(x, w_in, conv_w, a_log, dt_bias, norm_g, w_o):
    B, L, _ = x.shape
    proj = x @ w_in
    qkv, z, a, b = jnp.split(proj, [2 * GDN_QK_W + GDN_V_W, 2 * GDN_QK_W + 2 * GDN_V_W,
                                    2 * GDN_QK_W + 2 * GDN_V_W + GDN_V_HEADS], axis=-1)
    qkv = jax.nn.silu(causal_dwconv(qkv, conv_w)).astype(jnp.float32)
    q, k, v = jnp.split(qkv, [GDN_QK_W, 2 * GDN_QK_W], axis=-1)
    rep = GDN_V_HEADS // GDN_QK_HEADS
    q = l2norm(q.reshape(B, L, GDN_QK_HEADS, GDN_DK)) * (GDN_DK ** -0.5)
    k = l2norm(k.reshape(B, L, GDN_QK_HEADS, GDN_DK))
    q = jnp.repeat(q, rep, axis=2)
    k = jnp.repeat(k, rep, axis=2)
    v = v.reshape(B, L, GDN_V_HEADS, GDN_DV)
    beta = jax.nn.sigmoid(b.astype(jnp.float32))
    g = -jnp.exp(a_log.astype(jnp.float32)) * jax.nn.softplus(a.astype(jnp.float32) + dt_bias.astype(jnp.float32))
    o = gated_delta_rule(q, k, v, g, beta)
    zf = z.astype(jnp.float32).reshape(B, L, GDN_V_HEADS, GDN_DV)
    o = o * lax.rsqrt(jnp.mean(jnp.square(o), -1, keepdims=True) + RMS_EPS) * norm_g.astype(jnp.float32) * jax.nn.silu(zf)
    return o.reshape(B, L, GDN_V_W).astype(x.dtype) @ w_o


def rel_bucket(dist):
    max_exact = N_BUCKETS // 2
    d = jnp.maximum(dist, 0)
    df = jnp.maximum(d, 1).astype(jnp.float32)
    large = max_exact + (jnp.log(df / max_exact) / math.log(MAX_DISTANCE / max_exact)
                         * (N_BUCKETS - max_exact)).astype(jnp.int32)
    large = jnp.minimum(large, N_BUCKETS - 1)
    return jnp.where(d < max_exact, d, large)


def dsa_mixer(x, w_in, kidx_ln_g, kidx_ln_b, rel_bias, w_o):
    B, L, _ = x.shape
    k_top = min(TOPK_MAX, L // 4)
    proj = x @ w_in
    sq = DSA_HEADS * DSA_DH
    skv = DSA_KV_HEADS * DSA_DH
    si = IDX_HEADS * IDX_DIM
    q, k, v, qi, ki, wi = jnp.split(proj, [sq, sq + skv, sq + 2 * skv, sq + 2 * skv + si,
                                           sq + 2 * skv + si + IDX_DIM], axis=-1)
    q = q.reshape(B, L, DSA_HEADS, DSA_DH)
    k = k.reshape(B, L, DSA_KV_HEADS, DSA_DH)
    v = v.reshape(B, L, DSA_KV_HEADS, DSA_DH)
    qi = qi.reshape(B, L, IDX_HEADS, IDX_DIM)
    ki = layer_norm(ki, kidx_ln_g, kidx_ln_b).astype(jnp.float32)
    wi = wi * ((IDX_HEADS ** -0.5) * (IDX_DIM ** -0.5))
    nb = L // Q_BLOCK
    scale = DSA_DH ** -0.5
    key_pos = jnp.arange(L)
    bias_tab = rel_bias.astype(jnp.float32)

    def blocks(a):
        return jnp.moveaxis(a.reshape(B, nb, Q_BLOCK, *a.shape[2:]), 1, 0)

    def attend(args):
        q_b, qi_b, wi_b, s0 = args
        t = s0 + jnp.arange(Q_BLOCK)
        sc = jnp.einsum('bqhd,bsd->bqhs', qi_b.astype(jnp.float32), ki)
        score = jnp.einsum('bqhs,bqh->bqs', jax.nn.relu(sc), wi_b.astype(jnp.float32))
        causal = key_pos[None, :] <= t[:, None]
        score = jnp.where(causal[None], score, -jnp.inf)
        _, idx = lax.top_k(score, k_top)
        k_sel = jax.vmap(lambda kk, ii: kk[ii])(k, idx)
        v_sel = jax.vmap(lambda vv, ii: vv[ii])(v, idx)
        qg = q_b.reshape(B, Q_BLOCK, DSA_KV_HEADS, DSA_GROUP, DSA_DH)
        logits = jnp.einsum('bqkgd,bqskd->bqkgs', qg, k_sel).astype(jnp.float32) * scale
        dist = t[None, :, None] - idx
        bias = bias_tab[rel_bucket(dist)]
        bias = bias.reshape(B, Q_BLOCK, k_top, DSA_KV_HEADS, DSA_GROUP).transpose(0, 1, 3, 4, 2)
        valid = (dist >= 0)[:, :, None, None, :]
        logits = jnp.where(valid, logits + bias, -jnp.inf)
        probs = jax.nn.softmax(logits, axis=-1).astype(v.dtype)
        o = jnp.einsum('bqkgs,bqskd->bqkgd', probs, v_sel)
        return o.reshape(B, Q_BLOCK, DSA_HEADS * DSA_DH)

    starts = jnp.arange(nb, dtype=jnp.int32) * Q_BLOCK
    o = lax.map(attend, (blocks(q), blocks(qi), blocks(wi), starts))
    o = jnp.moveaxis(o, 0, 1).reshape(B, L, DSA_HEADS * DSA_DH)
    return o @ w_o


def conv_glu(x, w_gate, w_up, conv_w, w_down):
    gate = causal_dwconv(x @ w_gate, conv_w)
    return (jax.nn.silu(gate) * (x @ w_up)) @ w_down


def setup_inputs(seed: int = 0) -> dict:
    key = jax.random.key(seed)
    ks = jax.random.split(key, 32)

    def nrm(k, shape, scale):
        return jax.random.normal(k, shape, jnp.float32) * scale

    NA, NB, L = N_GDN_LAYERS, N_DSA_LAYERS, DEPTH
    x = nrm(ks[0], (BATCH, SEQ, D_MODEL), 1.0)
    p = nrm(ks[1], (DEPTH, BATCH, SEQ, PLE_DIM), 1.0)
    gdn_w_in = nrm(ks[2], (NA, D_MODEL, GDN_IN_W), D_MODEL ** -0.5)
    gdn_conv_w = nrm(ks[3], (NA, GDN_CONV, 2 * GDN_QK_W + GDN_V_W), GDN_CONV ** -0.5)
    gdn_a_log = jnp.log(jax.random.uniform(ks[4], (NA, GDN_V_HEADS), jnp.float32, 1.0, 16.0))
    dt = jnp.exp(jax.random.uniform(ks[5], (NA, GDN_V_HEADS), jnp.float32, math.log(1e-3), math.log(1e-1)))
    gdn_dt_bias = dt + jnp.log(-jnp.expm1(-dt))
    gdn_norm_g = 1.0 + nrm(ks[6], (NA, GDN_DV), 0.02)
    gdn_w_o = nrm(ks[7], (NA, GDN_V_W, D_MODEL), DN_BETA * GDN_V_W ** -0.5)
    dsa_w_in = nrm(ks[8], (NB, D_MODEL, DSA_IN_W), D_MODEL ** -0.5)
    dsa_kidx_ln_g = 1.0 + nrm(ks[9], (NB, IDX_DIM), 0.02)
    dsa_kidx_ln_b = nrm(ks[10], (NB, IDX_DIM), 0.02)
    dsa_w_o = nrm(ks[11], (NB, DSA_HEADS * DSA_DH, D_MODEL), DN_BETA * (DSA_HEADS * DSA_DH) ** -0.5)
    rel_bias = nrm(ks[12], (N_BUCKETS, DSA_HEADS), 0.5)
    ln1_g = 1.0 + nrm(ks[13], (L, D_MODEL), 0.02)
    ln1_b = nrm(ks[14], (L, D_MODEL), 0.02)
    ffn_w_gate = nrm(ks[15], (L, D_MODEL, D_FF), D_MODEL ** -0.5)
    ffn_w_up = nrm(ks[16], (L, D_MODEL, D_FF), D_MODEL ** -0.5)
    ffn_conv_w = nrm(ks[17], (L, FFN_CONV, D_FF), FFN_CONV ** -0.5)
    ffn_w_down = nrm(ks[18], (L, D_FF, D_MODEL), DN_BETA * D_FF ** -0.5)
    ln2_g = 1.0 + nrm(ks[19], (L, D_MODEL), 0.02)
    ln2_b = nrm(ks[20], (L, D_MODEL), 0.02)
    ple_w_proj = nrm(ks[21], (L, PLE_DIM, D_MODEL), 0.5 * PLE_DIM ** -0.5)
    ple_w_gate = nrm(ks[22], (L, D_MODEL, D_MODEL), D_MODEL ** -0.5)
    return {"x": x, "p": p,
            "gdn_w_in": gdn_w_in, "gdn_conv_w": gdn_conv_w, "gdn_a_log": gdn_a_log,
            "gdn_dt_bias": gdn_dt_bias, "gdn_norm_g": gdn_norm_g, "gdn_w_o": gdn_w_o,
            "dsa_w_in": dsa_w_in, "dsa_kidx_ln_g": dsa_kidx_ln_g, "dsa_kidx_ln_b": dsa_kidx_ln_b,
            "dsa_w_o": dsa_w_o, "rel_bias": rel_bias,
            "ln1_g": ln1_g, "ln1_b": ln1_b,
            "ffn_w_gate": ffn_w_gate, "ffn_w_up": ffn_w_up, "ffn_conv_w": ffn_conv_w, "ffn_w_down": ffn_w_down,
            "ln2_g": ln2_g, "ln2_b": ln2_b,
            "ple_w_proj": ple_w_proj, "ple_w_gate": ple_w_gate}


def reference(x, p, gdn_w_in, gdn_conv_w, gdn_a_log, gdn_dt_bias, gdn_norm_g, gdn_w_o,
              dsa_w_in, dsa_kidx_ln_g, dsa_kidx_ln_b, dsa_w_o, rel_bias,
              ln1_g, ln1_b, ffn_w_gate, ffn_w_up, ffn_conv_w, ffn_w_down, ln2_g, ln2_b,
              ple_w_proj, ple_w_gate):
    ia = 0
    ib = 0
    for i in range(DEPTH):
        if i % N_MIXERS == 0:
            h = gdn_mixer(x, gdn_w_in[ia], gdn_conv_w[ia], gdn_a_log[ia], gdn_dt_bias[ia],
                          gdn_norm_g[ia], gdn_w_o[ia])
            ia += 1
        else:
            h = dsa_mixer(x, dsa_w_in[ib], dsa_kidx_ln_g[ib], dsa_kidx_ln_b[ib], rel_bias, dsa_w_o[ib])
            ib += 1
        x = layer_norm(DN_ALPHA * x + h, ln1_g[i], ln1_b[i])
        f = conv_glu(x, ffn_w_gate[i], ffn_w_up[i], ffn_conv_w[i], ffn_w_down[i])
        x = layer_norm(DN_ALPHA * x + f, ln2_g[i], ln2_b[i])
        x = x + jax.nn.sigmoid(x @ ple_w_gate[i]) * (p[i] @ ple_w_proj[i])
    return x
```

```cpp
#include <hip/hip_runtime.h>
#include <hip/hip_cooperative_groups.h>
#include <cstdio>
namespace cg = cooperative_groups;
#define MIXER_STAGE 2
namespace pg8 {
#define PG8_LAS __attribute__((address_space(3)))
typedef unsigned short bf16_t;
typedef short bf16x8 __attribute__((ext_vector_type(8)));
typedef float f32x4 __attribute__((ext_vector_type(4)));
typedef unsigned u32x4 __attribute__((ext_vector_type(4)));
constexpr int BM = 256, BK = 64, HALF = 128, HTB = HALF * BK * 2  , STAGE_BYTES = 8 * HTB, NXCD = 8, WGM = 8;

__host__ __device__ __forceinline__ int lds_byte(int r, int c) { const int st = (r >> 4) * 2 + (c >> 5), rr = r & 15, cc = c & 31, ob = rr * 64 + cc * 2; return st * 1024 + (ob ^ (((ob >> 9) & 1) << 5)); }
__host__ __device__ __forceinline__ void stage_rc(int b, int& R, int& C) { const int st = b / 1024, sb = b % 1024, swz = sb ^ (((sb >> 9) & 1) << 5); R = (st >> 1) * 16 + swz / 64; C = (st & 1) * 32 + (swz % 64) / 2; }
__host__ __device__ __forceinline__ int perm32(int rho) { const int n = rho >> 4, i = rho & 15; return 8 * (i >> 2) + 4 * n + (i & 3); }

struct Unit { int pm, pn; };
struct Gemm { const bf16_t* A; const bf16_t* Bt; int M, N, K; };

struct StaticOrder {
    int nM, nN, nwg, G, c;
    __host__ __device__ void init(int M, int N, int G_, int c_) { nM = M / BM; nN = N / BM; nwg = nM * nN; G = G_; c = c_; }
    __host__ __device__ bool next(int i, Unit& u) const {
        const long L = (long)i * G + c; if (L >= nwg) return false;
        int wgid = (int)L; { const int q = nwg / NXCD, r = nwg % NXCD, xcd = wgid % NXCD, off = wgid / NXCD; wgid = (xcd < r ? xcd * (q + 1) : r * (q + 1) + (xcd - r) * q) + off; }
        const int nig = WGM * nN, gid = wgid / nig, fm = gid * WGM, gsz = (nM - fm) < WGM ? (nM - fm) : WGM;
        u.pm = fm + ((wgid % nig) % gsz); u.pn = (wgid % nig) / gsz; return true;
    }
    __device__ __forceinline__ void a_ready(const Unit&) const {}
    __device__ __forceinline__ void done(const Unit&) const {}
};
template <class Epi, class Sched, bool STAMP = false>
__device__ __forceinline__ void gemm_phase(PG8_LAS unsigned char* lds, const Gemm g, const Sched& S, const Epi& E, unsigned long long* stamps) {
    int tid_ = threadIdx.x; asm volatile("" : "+v"(tid_)); const int tid = tid_, wid = __builtin_amdgcn_readfirstlane(tid >> 6), lane = tid & 63, wr = wid >> 2, wc = wid & 3, fr = lane & 15, fq = lane >> 4;
    const int K = g.K, nt = K / BK;
    int ts_lo = 0, ts_hi = 0, nts = 0; const unsigned long long rt_entry = STAMP ? (unsigned long long)wall_clock64() : 0ull;
#define PG8_STAMP() do { if (STAMP && wid == 0 && nts < 64) { const unsigned long long _c = (unsigned long long)clock64(); \
        ts_lo = (lane == nts) ? (int)(unsigned)_c : ts_lo; ts_hi = (lane == nts) ? (int)(unsigned)(_c >> 32) : ts_hi; ++nts; } } while (0)
    PG8_STAMP();
    unsigned voffA[2], voffB[2];
#pragma unroll
    for (int i = 0; i < 2; ++i) { int R, C; stage_rc(tid * 16 + i * 8192, R, C); const int Rb = Epi::PERM ? ((R & ~31) + perm32(R & 31)) : R;
        voffA[i] = (unsigned)(R * K + C) * 2u; voffB[i] = (unsigned)(Rb * K + C) * 2u; }
    const size_t kstep = (size_t)(BK * 2);
    const size_t hstep = (size_t)HALF * K * 2;
    const size_t tstep = 2 * hstep;
    const unsigned ldsw = (unsigned)wid * 1024u;
    const int aoff = lds_byte(wr * 64 + fr, fq * 8), boff = lds_byte(wc * 32 + fr, fq * 8);
#define PG8_SA(b, h) (((b) * 2 + (h)) * HTB)
#define PG8_SB(b, h) ((4 + (b) * 2 + (h)) * HTB)
#define PG8_STAGE(bufoff, gbase, voff) do { _Pragma("unroll") for (int _i = 0; _i < 2; ++_i) \
        __builtin_amdgcn_global_load_lds((const unsigned*)((const char*)(gbase) + (voff)[_i]), (PG8_LAS unsigned*)(lds + (bufoff) + ldsw + _i * 8192), 16, 0, 0); } while (0)
#define PG8_LDA(dst, b, h) do { _Pragma("unroll") for (int m = 0; m < 4; ++m) _Pragma("unroll") for (int k = 0; k < 2; ++k) dst[m][k] = *(const PG8_LAS bf16x8*)(lds + PG8_SA(b, h) + aoff + m * 2048 + k * 1024); } while (0)
#define PG8_LDB(dst, b, h) do { _Pragma("unroll") for (int n = 0; n < 2; ++n) _Pragma("unroll") for (int k = 0; k < 2; ++k) dst[n][k] = *(const PG8_LAS bf16x8*)(lds + PG8_SB(b, h) + boff + n * 2048 + k * 1024); } while (0)
#define PG8_MMA(ai, bj, At, Bt) do { __builtin_amdgcn_s_setprio(1); _Pragma("unroll") for (int m = 0; m < 4; ++m) _Pragma("unroll") for (int n = 0; n < 2; ++n) _Pragma("unroll") for (int k = 0; k < 2; ++k) \
        acc[ai][bj][m][n] = __builtin_amdgcn_mfma_f32_16x16x32_bf16(Bt[n][k], At[m][k], acc[ai][bj][m][n], 0, 0, 0); __builtin_amdgcn_s_setprio(0); } while (0)
#define PG8_WAIT_V(n) asm volatile("s_waitcnt vmcnt(" #n ")" ::: "memory")
#define PG8_WAIT_L(n) asm volatile("s_waitcnt lgkmcnt(" #n ")" ::: "memory")
#define PG8_BAR __builtin_amdgcn_s_barrier()
#define PG8_SCHED __builtin_amdgcn_sched_barrier(0)
    Unit cur, nxt; int ui = 0;
    if (!S.next(0, cur)) return;
    f32x4 acc[2][2][4][2];
#pragma unroll
    for (int a = 0; a < 2; ++a)
#pragma unroll
        for (int b = 0; b < 2; ++b)
#pragma unroll
            for (int m = 0; m < 4; ++m)
#pragma unroll
                for (int n = 0; n < 2; ++n) acc[a][b][m][n] = (f32x4){0.f, 0.f, 0.f, 0.f};
    bf16x8 At[4][2], B0[2][2], B1[2][2];
    const char* cA = (const char*)g.A + (size_t)cur.pm * tstep; const char* cB = (const char*)g.Bt + (size_t)cur.pn * tstep;
    S.a_ready(cur);
    PG8_STAGE(PG8_SB(0, 0), cB, voffB); PG8_STAGE(PG8_SA(0, 0), cA, voffA); PG8_STAGE(PG8_SB(0, 1), cB + hstep, voffB); PG8_STAGE(PG8_SA(0, 1), cA + hstep, voffA);
    if (wr == 1) PG8_BAR;
    PG8_WAIT_V(4); PG8_BAR;
    PG8_STAGE(PG8_SB(1, 0), cB + kstep, voffB); PG8_STAGE(PG8_SA(1, 0), cA + kstep, voffA); PG8_STAGE(PG8_SB(1, 1), cB + hstep + kstep, voffB);
    PG8_WAIT_V(6); PG8_BAR;
    PG8_STAMP();
    for (;;) {
        const bool has_next = S.next(ui + 1, nxt);
        const char* nA = has_next ? (const char*)g.A + (size_t)nxt.pm * tstep : cA; const char* nB = has_next ? (const char*)g.Bt + (size_t)nxt.pn * tstep : cB;
        for (int t = 0; t < nt; t += 2) {
            const bool last = (t == nt - 2);
            const char* a1 = cA + (size_t)(t + 1) * kstep;
            const char* a2 = last ? nA : cA + (size_t)(t + 2) * kstep; const char* b2 = last ? nB : cB + (size_t)(t + 2) * kstep;
            const char* a3 = a2 + kstep; const char* b3 = b2 + kstep;
            if (last && has_next) S.a_ready(nxt);
            PG8_LDB(B0, 0, 0); PG8_SCHED; PG8_LDA(At, 0, 0); PG8_STAGE(PG8_SA(1, 1), a1 + hstep, voffA);
            PG8_WAIT_L(8); PG8_BAR; PG8_WAIT_L(0); PG8_MMA(0, 0, At, B0); PG8_BAR; PG8_SCHED;
            PG8_LDB(B1, 0, 1); PG8_STAGE(PG8_SB(0, 0), b2, voffB);
            PG8_BAR; PG8_WAIT_L(0); PG8_MMA(0, 1, At, B1); PG8_BAR;
            PG8_LDA(At, 0, 1); PG8_STAGE(PG8_SA(0, 0), a2, voffA);
            PG8_BAR; PG8_WAIT_L(0); PG8_MMA(1, 0, At, B0); PG8_BAR; PG8_SCHED;
            PG8_STAGE(PG8_SB(0, 1), b2 + hstep, voffB);
            PG8_WAIT_V(6); PG8_BAR; PG8_MMA(1, 1, At, B1); PG8_BAR;
            PG8_LDB(B0, 1, 0); PG8_SCHED; PG8_LDA(At, 1, 0); PG8_STAGE(PG8_SA(0, 1), a2 + hstep, voffA);
            PG8_WAIT_L(8); PG8_BAR; PG8_WAIT_L(0); PG8_MMA(0, 0, At, B0); PG8_BAR; PG8_SCHED;
            PG8_LDB(B1, 1, 1); PG8_STAGE(PG8_SB(1, 0), b3, voffB);
            PG8_BAR; PG8_WAIT_L(0); PG8_MMA(0, 1, At, B1); PG8_BAR;
            PG8_LDA(At, 1, 1); PG8_STAGE(PG8_SA(1, 0), a3, voffA);
            PG8_BAR; PG8_WAIT_L(0); PG8_MMA(1, 0, At, B0); PG8_BAR; PG8_SCHED;
            PG8_STAGE(PG8_SB(1, 1), b3 + hstep, voffB);
            PG8_WAIT_V(6); PG8_BAR; PG8_MMA(1, 1, At, B1); PG8_BAR;
        }
        PG8_STAMP();
        if constexpr (!Epi::AFTER_DRAIN) { E(acc, cur, wr, wc, fr, fq); S.done(cur); }
        PG8_STAMP();
        if (!has_next) break;
#pragma unroll
        for (int a = 0; a < 2; ++a)
#pragma unroll
            for (int b = 0; b < 2; ++b)
#pragma unroll
                for (int m = 0; m < 4; ++m)
#pragma unroll
                    for (int n = 0; n < 2; ++n) acc[a][b][m][n] = (f32x4){0.f, 0.f, 0.f, 0.f};
        cur = nxt; cA = nA; cB = nB; ++ui;
    }
    PG8_WAIT_V(0);
    if (wr == 0) PG8_BAR;
    PG8_BAR;
    if constexpr (Epi::AFTER_DRAIN) { E.fused(acc, cur, wr, wc, fr, fq, lds, wid, lane); S.done(cur); }
    PG8_STAMP();
    if (STAMP && wid == 0) { stamps[lane] = lane < nts ? (((unsigned long long)(unsigned)ts_hi << 32) | (unsigned)ts_lo) : 0ull;
        if (lane == 62) stamps[62] = rt_entry; if (lane == 63) stamps[63] = (unsigned long long)wall_clock64(); }
#undef PG8_STAMP
#undef PG8_SA
#undef PG8_SB
#undef PG8_STAGE
#undef PG8_LDA
#undef PG8_LDB
#undef PG8_MMA
#undef PG8_WAIT_V
#undef PG8_WAIT_L
#undef PG8_BAR
#undef PG8_SCHED
}
}

#include <cstdio>
#include <ctime>
#include <cstdlib>
#include <cstring>
#include <cmath>
#include <vector>
#include <algorithm>
#define CK(x) do { hipError_t e_ = (x); if (e_ != hipSuccess) { fprintf(stderr, "HIP %s:%d %s\n", __FILE__, __LINE__, hipGetErrorString(e_)); exit(2); } } while (0)
using pg8::bf16_t; using pg8::bf16x8; using pg8::f32x4; using pg8::u32x4;
typedef float f32x16 __attribute__((ext_vector_type(16)));
typedef unsigned u32x2 __attribute__((ext_vector_type(2)));
#define LAS PG8_LAS
constexpr int T = 16384, DM = 2048;
constexpr size_t MiB = 1ull << 20;
constexpr int LDS_BYTES = 149504;
constexpr float DN_ALPHA = 1.4142135623730951f;

struct KP { const float* in[23]; float* out; unsigned char* ws; };

__device__ __forceinline__ unsigned short f2bf(float f) { unsigned u = __float_as_uint(f); u += 0x7FFFu + ((u >> 16) & 1u); return (unsigned short)(u >> 16); }
__device__ __forceinline__ float bf2f(unsigned short b) { return __uint_as_float(((unsigned)b) << 16); }
__device__ __forceinline__ unsigned pack2(float lo, float hi) { return (unsigned)f2bf(lo) | ((unsigned)f2bf(hi) << 16); }
__device__ __forceinline__ float bflo(unsigned w) { return __uint_as_float(w << 16); }
__device__ __forceinline__ float bfhi(unsigned w) { return __uint_as_float(w & 0xffff0000u); }
__device__ __forceinline__ void unpack8(const u32x4 v, float* f) { f[0] = bflo(v.x); f[1] = bfhi(v.x); f[2] = bflo(v.y); f[3] = bfhi(v.y); f[4] = bflo(v.z); f[5] = bfhi(v.z); f[6] = bflo(v.w); f[7] = bfhi(v.w); }
__device__ __forceinline__ u32x4 pack8(const float* f) { u32x4 w; w.x = pack2(f[0], f[1]); w.y = pack2(f[2], f[3]); w.z = pack2(f[4], f[5]); w.w = pack2(f[6], f[7]); return w; }
__device__ __forceinline__ float wave_sum(float v) { v += __shfl_xor(v, 32); v += __shfl_xor(v, 16); v += __shfl_xor(v, 8); v += __shfl_xor(v, 4); v += __shfl_xor(v, 2); v += __shfl_xor(v, 1); return v; }
__device__ __forceinline__ float wave_max(float v) { v = fmaxf(v, __shfl_xor(v, 32)); v = fmaxf(v, __shfl_xor(v, 16)); v = fmaxf(v, __shfl_xor(v, 8)); v = fmaxf(v, __shfl_xor(v, 4)); v = fmaxf(v, __shfl_xor(v, 2)); v = fmaxf(v, __shfl_xor(v, 1)); return v; }
__device__ __forceinline__ void wave_sync() { __builtin_amdgcn_fence(__ATOMIC_SEQ_CST, "wavefront"); __builtin_amdgcn_wave_barrier(); __builtin_amdgcn_fence(__ATOMIC_SEQ_CST, "wavefront"); }
__device__ __forceinline__ float siluf(float x) { return x / (1.0f + __expf(-x)); }
__device__ __forceinline__ float sigmoidf_(float x) { return 1.0f / (1.0f + __expf(-x)); }

__device__ __forceinline__ void convT_tiles(const float* __restrict__ in, int K, int N, int Npad, bf16_t* __restrict__ out, LAS float* tile, int& tbase) {
    const int G = gridDim.x, tid = threadIdx.x;
    const int ntn = Npad >> 6, ntiles = (K >> 6) * ntn;
    int first = ((int)blockIdx.x - tbase) % G; if (first < 0) first += G;
    for (int t = first; t < ntiles; t += G) {
        const int kt = t / ntn, nt = t - kt * ntn, k0 = kt << 6, n0 = nt << 6;
#pragma unroll
        for (int i = 0; i < 2; ++i) {
            const int e = tid + i * 512, kk = e >> 4, n4 = (e & 15) << 2, n = n0 + n4;
            float4 v = make_float4(0.f, 0.f, 0.f, 0.f);
            if (n < N) v = *(const float4*)(in + (size_t)(k0 + kk) * N + n);
            LAS float* d = tile + kk * 65 + n4; d[0] = v.x; d[1] = v.y; d[2] = v.z; d[3] = v.w;
        }
        __syncthreads();
        {
            const int n = tid >> 3, k8 = (tid & 7) << 3; float f[8];
#pragma unroll
            for (int j = 0; j < 8; ++j) f[j] = tile[(k8 + j) * 65 + n];
            *(u32x4*)(out + (size_t)(n0 + n) * K + k0 + k8) = pack8(f);
        }
        __syncthreads();
    }
    tbase = (tbase + ntiles) % G;
}
__device__ __forceinline__ void cvt_bf16(const float* __restrict__ in, bf16_t* __restrict__ out, size_t n8) {
    for (size_t i = (size_t)blockIdx.x * 512 + threadIdx.x; i < n8; i += (size_t)gridDim.x * 512) {
        const float4 a = ((const float4*)in)[2 * i], b = ((const float4*)in)[2 * i + 1];
        u32x4 w; w.x = pack2(a.x, a.y); w.y = pack2(a.z, a.w); w.z = pack2(b.x, b.y); w.w = pack2(b.z, b.w);
        ((u32x4*)out)[i] = w;
    }
}

__device__ __forceinline__ void ln_phase(float* Y, const float* __restrict__ g, const float* __restrict__ b, bf16_t* xb, bool wf32) {
    const int lane = threadIdx.x & 63, gw = blockIdx.x * 8 + (threadIdx.x >> 6), nw = gridDim.x * 8;
    for (int row = gw; row < T; row += nw) {
        float4* yr = (float4*)(Y + (size_t)row * DM);
        float4 v[8]; float s = 0.f;
#pragma unroll
        for (int i = 0; i < 8; ++i) { v[i] = yr[i * 64 + lane]; s += (v[i].x + v[i].y) + (v[i].z + v[i].w); }
        s = wave_sum(s); const float mean = s * (1.0f / 2048.0f);
        float q = 0.f;
#pragma unroll
        for (int i = 0; i < 8; ++i) { const float a = v[i].x - mean, bb = v[i].y - mean, c = v[i].z - mean, d = v[i].w - mean; q += (a * a + bb * bb) + (c * c + d * d); }
        q = wave_sum(q); const float rstd = rsqrtf(q * (1.0f / 2048.0f) + 1e-5f);
#pragma unroll
        for (int i = 0; i < 8; ++i) {
            const int c = (i * 64 + lane) * 4; const float4 g4 = *(const float4*)(g + c), b4 = *(const float4*)(b + c);
            float4 o; o.x = (v[i].x - mean) * rstd * g4.x + b4.x; o.y = (v[i].y - mean) * rstd * g4.y + b4.y; o.z = (v[i].z - mean) * rstd * g4.z + b4.z; o.w = (v[i].w - mean) * rstd * g4.w + b4.w;
            uint2 w; w.x = pack2(o.x, o.y); w.y = pack2(o.z, o.w);
            *(uint2*)(xb + (size_t)row * DM + c) = w;
            if (wf32) yr[i * 64 + lane] = o;
        }
    }
}

__device__ __forceinline__ void convglu_phase(const bf16_t* __restrict__ Gm, bf16_t* U, const float* __restrict__ cw) {
    const int lane = threadIdx.x & 63, gw = blockIdx.x * 8 + (threadIdx.x >> 6), nw = gridDim.x * 8;
    for (int u = gw; u < 2560; u += nw) {
        const int cgp = u % 10, rb = u / 10, c0 = cgp * 512 + lane * 8, r0 = rb * 64;
        float w0[8], w1[8], w2[8], p2[8], p1[8];
#pragma unroll
        for (int k = 0; k < 8; ++k) { w0[k] = cw[c0 + k]; w1[k] = cw[5120 + c0 + k]; w2[k] = cw[10240 + c0 + k]; p2[k] = 0.f; p1[k] = 0.f; }
        if (r0 > 0) { unpack8(*(const u32x4*)(Gm + (size_t)(r0 - 2) * 5120 + c0), p2); unpack8(*(const u32x4*)(Gm + (size_t)(r0 - 1) * 5120 + c0), p1); }
        for (int r = r0; r < r0 + 64; ++r) {
            float gv[8], uv[8], hv[8];
            unpack8(*(const u32x4*)(Gm + (size_t)r * 5120 + c0), gv); unpack8(*(const u32x4*)(U + (size_t)r * 5120 + c0), uv);
#pragma unroll
            for (int k = 0; k < 8; ++k) { const float gate = w0[k] * p2[k] + w1[k] * p1[k] + w2[k] * gv[k]; hv[k] = siluf(gate) * uv[k]; p2[k] = p1[k]; p1[k] = gv[k]; }
            *(u32x4*)(U + (size_t)r * 5120 + c0) = pack8(hv);
        }
    }
}

__device__ __forceinline__ uint2 pk4(const f32x4 v) { uint2 w; w.x = pack2(v[0], v[1]); w.y = pack2(v[2], v[3]); return w; }
struct Seg { bf16_t* ptr; int pn1; int pn_stride; int chunk_stride; int row_stride; int bj_stride; };
struct F32Tgt { float* ptr; int lc0, lc1, ld; float scale; };
struct EpiRoute {
    static constexpr bool PERM = false, AFTER_DRAIN = false;
    Seg seg[4]; int nseg; bf16_t* halo; int halo_pn; int fpn; F32Tgt ft0, ft1;
    static __device__ __forceinline__ void f32store(const F32Tgt& t, const f32x4 (&acc)[2][2][4][2], int row0, int lc0) {
        if (!t.ptr) return;
#pragma unroll
        for (int bj = 0; bj < 2; ++bj)
#pragma unroll
            for (int n = 0; n < 2; ++n) {
                const int lc = lc0 + bj * 128 + n * 16;
                if (lc >= t.lc0 && lc < t.lc1) {
#pragma unroll
                    for (int ai = 0; ai < 2; ++ai)
#pragma unroll
                        for (int m = 0; m < 4; ++m) *(f32x4*)(t.ptr + (size_t)(row0 + ai * 128 + m * 16) * t.ld + (lc - t.lc0)) = acc[ai][bj][m][n] * t.scale;
                }
            }
    }
    __device__ __forceinline__ void operator()(const f32x4 (&acc)[2][2][4][2], const pg8::Unit& u, int wr, int wc, int fr, int fq) const {
        const int row0 = u.pm * 256 + wr * 64 + fr, lc0 = wc * 32 + 4 * fq, pn = u.pn;
        if (pn == fpn) { f32store(ft0, acc, row0, lc0); f32store(ft1, acc, row0, lc0); return; }
        Seg sg = seg[0]; int pnb = 0;
        if (nseg > 1 && pn >= seg[0].pn1) { sg = seg[1]; pnb = seg[0].pn1; }
        if (nseg > 2 && pn >= seg[1].pn1) { sg = seg[2]; pnb = seg[1].pn1; }
        if (nseg > 3 && pn >= seg[2].pn1) { sg = seg[3]; pnb = seg[2].pn1; }
        if (pn >= sg.pn1) return;
        bf16_t* base = sg.ptr + (size_t)(pn - pnb) * sg.pn_stride + lc0;
        const int cs = sg.chunk_stride, rs = sg.row_stride, bs = sg.bj_stride;
#pragma unroll
        for (int ai = 0; ai < 2; ++ai)
#pragma unroll
            for (int m = 0; m < 4; ++m) {
                const int row = row0 + ai * 128 + m * 16;
                bf16_t* rp = base + (size_t)(row >> 6) * cs + (row & 63) * rs;
#pragma unroll
                for (int bj = 0; bj < 2; ++bj)
#pragma unroll
                    for (int n = 0; n < 2; ++n) *(uint2*)(rp + bj * bs + n * 16) = pk4(acc[ai][bj][m][n]);
            }
        if (halo && pn < halo_pn && fr >= 13) {
#pragma unroll
            for (int ai = 0; ai < 2; ++ai) {
                const int row = row0 + ai * 128 + 48;
                bf16_t* hp = halo + ((size_t)(row >> 6) * 3 + (fr - 13)) * 8192 + pn * 256 + lc0;
#pragma unroll
                for (int bj = 0; bj < 2; ++bj)
#pragma unroll
                    for (int n = 0; n < 2; ++n) *(uint2*)(hp + bj * 128 + n * 16) = pk4(acc[ai][bj][3][n]);
            }
        }
    }
};
struct EpiResid {
    static constexpr bool PERM = false, AFTER_DRAIN = false;
    const float* rf; const bf16_t* rb; float* Y;
    __device__ __forceinline__ void operator()(const f32x4 (&acc)[2][2][4][2], const pg8::Unit& u, int wr, int wc, int fr, int fq) const {
        const int row0 = u.pm * 256 + wr * 64 + fr, col0 = u.pn * 256 + wc * 32 + 4 * fq;
#pragma unroll
        for (int ai = 0; ai < 2; ++ai)
#pragma unroll
            for (int m = 0; m < 4; ++m) {
                const size_t o = (size_t)(row0 + ai * 128 + m * 16) * DM + col0;
#pragma unroll
                for (int bj = 0; bj < 2; ++bj)
#pragma unroll
                    for (int n = 0; n < 2; ++n) {
                        f32x4 r;
                        if (rf) r = *(const f32x4*)(rf + o + bj * 128 + n * 16);
                        else { const uint2 w = *(const uint2*)(rb + o + bj * 128 + n * 16); r[0] = bflo(w.x); r[1] = bfhi(w.x); r[2] = bflo(w.y); r[3] = bfhi(w.y); }
                        *(f32x4*)(Y + o + bj * 128 + n * 16) = r * DN_ALPHA + acc[ai][bj][m][n];
                    }
            }
    }
};
struct EpiPle {
    static constexpr bool PERM = false, AFTER_DRAIN = false;
    const float* x2; const bf16_t* PP; bf16_t* xb; float* fo;
    __device__ __forceinline__ void operator()(const f32x4 (&acc)[2][2][4][2], const pg8::Unit& u, int wr, int wc, int fr, int fq) const {
        const int row0 = u.pm * 256 + wr * 64 + fr, col0 = u.pn * 256 + wc * 32 + 4 * fq;
#pragma unroll
        for (int ai = 0; ai < 2; ++ai)
#pragma unroll
            for (int m = 0; m < 4; ++m) {
                const size_t o = (size_t)(row0 + ai * 128 + m * 16) * DM + col0;
#pragma unroll
                for (int bj = 0; bj < 2; ++bj)
#pragma unroll
                    for (int n = 0; n < 2; ++n) {
                        const size_t oo = o + bj * 128 + n * 16; const f32x4 v = acc[ai][bj][m][n];
                        const f32x4 x = *(const f32x4*)(x2 + oo); const uint2 w = *(const uint2*)(PP + oo);
                        f32x4 r; r[0] = x[0] + sigmoidf_(v[0]) * bflo(w.x); r[1] = x[1] + sigmoidf_(v[1]) * bfhi(w.x); r[2] = x[2] + sigmoidf_(v[2]) * bflo(w.y); r[3] = x[3] + sigmoidf_(v[3]) * bfhi(w.y);
                        if (xb) *(uint2*)(xb + oo) = pk4(r); else *(f32x4*)(fo + oo) = r;
                    }
            }
    }
};
template <class E> __device__ __forceinline__ void run_gemm(LAS unsigned char* lds, const bf16_t* A, const bf16_t* Bt, int N, int K, const E& e) {
    pg8::Gemm g; g.A = A; g.Bt = Bt; g.M = T; g.N = N; g.K = K;
    pg8::StaticOrder S; S.init(T, N, (int)gridDim.x, (int)blockIdx.x);
    pg8::gemm_phase<E, pg8::StaticOrder, false>(lds, g, S, e, nullptr);
}
__device__ __forceinline__ Seg mkseg(bf16_t* p, int pn1, int pns, int cs, int rs, int bs) { Seg s; s.ptr = p; s.pn1 = pn1; s.pn_stride = pns; s.chunk_stride = cs; s.row_stride = rs; s.bj_stride = bs; return s; }
__device__ __forceinline__ EpiRoute mkroute() { EpiRoute e; e.nseg = 0; e.halo = nullptr; e.halo_pn = 0; e.fpn = -1; e.ft0.ptr = nullptr; e.ft1.ptr = nullptr;
    for (int i = 0; i < 4; ++i) e.seg[i] = mkseg(nullptr, 0, 0, 0, 0, 0);
    e.ft0.lc0 = 0; e.ft0.lc1 = 0; e.ft0.ld = 0; e.ft0.scale = 1.f; e.ft1 = e.ft0; return e; }
__device__ __forceinline__ bf16_t* gdn_wptr(unsigned char* ws, int h) { return (bf16_t*)(ws + (h < 12 ? (size_t)h * 4 * MiB : (size_t)(497 + (h - 12) * 4) * MiB)); }

__device__ __forceinline__ void gdn_g1(const KP& p, unsigned char* ws, LAS unsigned char* ldsb) {
    LAS float* qs = (LAS float*)ldsb; LAS float* ks = qs + 64 * 129; LAS float* KKs = ks + 64 * 129; LAS float* QKs = KKs + 64 * 65;
    LAS float* Am = QKs + 64 * 65; LAS float* gcs = Am + 2 * 4096; LAS float* bts = gcs + 128;
    bf16_t* Qb = (bf16_t*)(ws + 113 * MiB); bf16_t* Kb = (bf16_t*)(ws + 177 * MiB); bf16_t* Vb = (bf16_t*)(ws + 241 * MiB);
    float* AB = (float*)(ws + 577 * MiB); const bf16_t* HALO = (const bf16_t*)(ws + 581 * MiB); bf16_t* qkd = (bf16_t*)(ws + 49 * MiB); float* gcb = (float*)(ws + 601 * MiB);
    const float* convw = p.in[3]; const float* a_log = p.in[4]; const float* dt_bias = p.in[5];
    int tid_ = threadIdx.x; asm volatile("" : "+v"(tid_)); const int tid = tid_, lane = tid & 63, wv = tid >> 6;
    for (int unit = blockIdx.x; unit < 4096; unit += gridDim.x) {
        const int j = unit & 15, n = unit >> 4;
        {
            const int c = tid & 127, rg = tid >> 7;
#pragma unroll
            for (int which = 0; which < 2; ++which) {
                const bf16_t* src = (which ? Kb : Qb) + (size_t)(n * 16 + j) * 8192 + c;
                const int ch = which * 2048 + j * 128 + c;
                const float w0 = convw[ch], w1 = convw[8192 + ch], w2 = convw[2 * 8192 + ch], w3 = convw[3 * 8192 + ch];
                float xm3 = 0.f, xm2 = 0.f, xm1 = 0.f;
                if (rg > 0) { xm3 = bf2f(src[(rg * 16 - 3) * 128]); xm2 = bf2f(src[(rg * 16 - 2) * 128]); xm1 = bf2f(src[(rg * 16 - 1) * 128]); }
                else if (n > 0) { const bf16_t* hp = HALO + (size_t)(n - 1) * 3 * 8192 + ch; xm3 = bf2f(hp[0]); xm2 = bf2f(hp[8192]); xm1 = bf2f(hp[2 * 8192]); }
                LAS float* dst = which ? ks : qs;
#pragma unroll
                for (int i = 0; i < 16; ++i) {
                    const float x0 = bf2f(src[(rg * 16 + i) * 128]);
                    const float y = w0 * xm3 + w1 * xm2 + w2 * xm1 + w3 * x0;
                    dst[(rg * 16 + i) * 129 + c] = siluf(y);
                    xm3 = xm2; xm2 = xm1; xm1 = x0;
                }
            }
        }
        __syncthreads();
#pragma unroll
        for (int rr = 0; rr < 8; ++rr) {
            const int i = wv * 8 + rr;
            float a0 = qs[i * 129 + lane], a1 = qs[i * 129 + 64 + lane];
            float ss = wave_sum(a0 * a0 + a1 * a1); float sc = rsqrtf(ss + 1e-6f) * 0.08838834764831845f;
            qs[i * 129 + lane] = a0 * sc; qs[i * 129 + 64 + lane] = a1 * sc;
            a0 = ks[i * 129 + lane]; a1 = ks[i * 129 + 64 + lane];
            ss = wave_sum(a0 * a0 + a1 * a1); sc = rsqrtf(ss + 1e-6f);
            ks[i * 129 + lane] = a0 * sc; ks[i * 129 + 64 + lane] = a1 * sc;
        }
        __syncthreads();
        {
            const int i = tid >> 3, j8 = (tid & 7) * 8;
            float aK[8], aQ[8];
#pragma unroll
            for (int jj = 0; jj < 8; ++jj) { aK[jj] = 0.f; aQ[jj] = 0.f; }
            for (int d = 0; d < 128; ++d) {
                const float qv = qs[i * 129 + d], kv = ks[i * 129 + d];
#pragma unroll
                for (int jj = 0; jj < 8; ++jj) { const float kj = ks[(j8 + jj) * 129 + d]; aK[jj] += kv * kj; aQ[jj] += qv * kj; }
            }
#pragma unroll
            for (int jj = 0; jj < 8; ++jj) { KKs[i * 65 + j8 + jj] = aK[jj]; QKs[i * 65 + j8 + jj] = aQ[jj]; }
            {
                const int d0 = (tid & 7) * 16; float f[16];
#pragma unroll
                for (int e = 0; e < 16; ++e) f[e] = qs[i * 129 + d0 + e];
                bf16_t* dst = Qb + (size_t)(n * 16 + j) * 8192 + i * 128 + d0;
                *(u32x4*)dst = pack8(f); *(u32x4*)(dst + 8) = pack8(f + 8);
            }
            {
                const int d = tid >> 2, i0 = (tid & 3) * 16; float f[16];
#pragma unroll
                for (int e = 0; e < 16; ++e) f[e] = ks[(i0 + e) * 129 + d];
                bf16_t* dst = Kb + (size_t)(n * 16 + j) * 8192 + d * 64 + i0;
                *(u32x4*)dst = pack8(f); *(u32x4*)(dst + 8) = pack8(f + 8);
            }
        }
        int tl_ = tid & 255; asm volatile("" : "+v"(tl_));
        const int hh = tid >> 8, tl = tl_, h = 2 * j + hh;
        if (tl < 64) {
            const int row = n * 64 + tl;
            const float a = AB[(size_t)row * 64 + h], b = AB[(size_t)row * 64 + 32 + h];
            const float x = a + dt_bias[h];
            const float sp = (x > 20.f) ? x : log1pf(expf(x));
            float gc = -expf(a_log[h]) * sp;
#pragma unroll
            for (int off = 1; off < 64; off <<= 1) { const float t = __shfl_up(gc, off); if (lane >= off) gc += t; }
            gcs[hh * 64 + tl] = gc; bts[hh * 64 + tl] = 1.0f / (1.0f + expf(-b));
            gcb[(size_t)h * T + row] = gc;
        }
        __syncthreads();
        {
            const int i = tl >> 2, jx0 = (tl & 3) * 16;
            const float gi = gcs[hh * 64 + i], bi = bts[hh * 64 + i]; float f[16];
#pragma unroll
            for (int k = 0; k < 16; ++k) {
                const int jx = jx0 + k;
                const float dec = (jx <= i) ? __expf(gi - gcs[hh * 64 + jx]) : 0.f;
                Am[hh * 4096 + i * 64 + jx] = (jx < i) ? bi * KKs[i * 65 + jx] * dec : 0.f;
                f[k] = QKs[i * 65 + jx] * dec;
            }
            bf16_t* dst = qkd + ((size_t)(h * 256 + n) * 64 + i) * 64 + jx0;
            *(u32x4*)dst = pack8(f); *(u32x4*)(dst + 8) = pack8(f + 8);
        }
        __syncthreads();
        {
            const int c = tl; float X[64];
            LAS const float* bt = bts + hh * 64; LAS const float* gcp = gcs + hh * 64;
            if (c < 128) {
                const bf16_t* src = Vb + (size_t)(n * 32 + h) * 8192 + c;
                const int ch = 4096 + h * 128 + c;
                const float w0 = convw[ch], w1 = convw[8192 + ch], w2 = convw[2 * 8192 + ch], w3 = convw[3 * 8192 + ch];
                float xm3 = 0.f, xm2 = 0.f, xm1 = 0.f;
                if (n > 0) { const bf16_t* hp = HALO + (size_t)(n - 1) * 3 * 8192 + ch; xm3 = bf2f(hp[0]); xm2 = bf2f(hp[8192]); xm1 = bf2f(hp[2 * 8192]); }
#pragma unroll
                for (int i = 0; i < 64; ++i) {
                    const float x0 = bf2f(src[i * 128]);
                    const float y = w0 * xm3 + w1 * xm2 + w2 * xm1 + w3 * x0;
                    X[i] = bt[i] * siluf(y);
                    xm3 = xm2; xm2 = xm1; xm1 = x0;
                }
            } else {
                const int d = c - 128;
#pragma unroll
                for (int i = 0; i < 64; ++i) X[i] = bt[i] * __expf(gcp[i]) * ks[i * 129 + d];
            }
            LAS const float* Ah = Am + hh * 4096;
#pragma unroll
            for (int i = 1; i < 64; ++i) {
                float s0 = 0.f, s1 = 0.f, s2 = 0.f, s3 = 0.f;
#pragma unroll
                for (int j4 = 0; j4 < (i + 3) / 4; ++j4) {
                    const f32x4 a4 = *(LAS const f32x4*)(Ah + i * 64 + j4 * 4);
                    if (j4 * 4 + 0 < i) s0 += a4[0] * X[j4 * 4 + 0];
                    if (j4 * 4 + 1 < i) s1 += a4[1] * X[j4 * 4 + 1];
                    if (j4 * 4 + 2 < i) s2 += a4[2] * X[j4 * 4 + 2];
                    if (j4 * 4 + 3 < i) s3 += a4[3] * X[j4 * 4 + 3];
                }
                X[i] -= (s0 + s1) + (s2 + s3);
            }
            if (c < 128) {
                bf16_t* dst = Vb + (size_t)(n * 32 + h) * 8192 + c;
#pragma unroll
                for (int i = 0; i < 64; ++i) dst[i * 128] = f2bf(X[i]);
            } else {
                bf16_t* dst = gdn_wptr(ws, h) + (size_t)(n * 64) * 128 + (c - 128);
#pragma unroll
                for (int i = 0; i < 64; ++i) dst[i * 128] = f2bf(X[i]);
            }
        }
        __syncthreads();
    }
}

__device__ __forceinline__ void gdn_g2(unsigned char* ws, LAS unsigned char* lds) {
    constexpr int BUFSZ = 62464, OFF_W = 0, OFF_Q = 17408, OFF_K = 34816, OFF_QK = 53248, OFF_ST = 2 * BUFSZ, OFF_VN = OFF_ST + 4352, OFF_VS = OFF_VN + 2304;
    const bf16_t* Qb = (const bf16_t*)(ws + 113 * MiB); const bf16_t* Kb = (const bf16_t*)(ws + 177 * MiB); bf16_t* Vb = (bf16_t*)(ws + 241 * MiB);
    const bf16_t* qkd = (const bf16_t*)(ws + 49 * MiB); const float* gcb = (const float*)(ws + 601 * MiB);
    int tid_ = threadIdx.x; asm volatile("" : "+v"(tid_)); const int tid = tid_, lane = tid & 63, w = tid >> 6, l15 = lane & 15, lq = lane >> 4, mt = w & 3;
    for (int unit = blockIdx.x; unit < 256; unit += gridDim.x) {
        const int h = unit >> 3, s = unit & 7, j = h >> 1;
        const bf16_t* wh = gdn_wptr(ws, h);
        const float* gch = gcb + (size_t)h * T;
        f32x4 Sacc = {0.f, 0.f, 0.f, 0.f};
        for (int i = tid; i < (4352 + 2304 + 2304) / 4; i += 512) ((LAS unsigned*)(lds + OFF_ST))[i] = 0u;
        u32x4 R[7]; unsigned short un[4]; f32x4 gcn; float gln;
#define G2_LOAD(nn) do { \
            _Pragma("unroll") for (int k = 0; k < 7; ++k) { const int pid = tid + 512 * k; const bf16_t* src; \
                if (k < 2) src = wh + (size_t)(nn) * 8192 + (size_t)pid * 8; \
                else if (k < 4) src = Qb + (size_t)((nn) * 16 + j) * 8192 + (size_t)(pid - 1024) * 8; \
                else if (k < 6) src = Kb + (size_t)((nn) * 16 + j) * 8192 + (size_t)(pid - 2048) * 8; \
                else src = qkd + (size_t)(h * 256 + (nn)) * 4096 + (size_t)(pid - 3072) * 8; \
                R[k] = *(const u32x4*)src; } \
            { const bf16_t* up = Vb + (size_t)((nn) * 32 + h) * 8192 + (size_t)(16 * mt + 4 * lq) * 128 + s * 16 + l15; \
              un[0] = up[0]; un[1] = up[128]; un[2] = up[256]; un[3] = up[384]; } \
            gcn = *(const f32x4*)(gch + (nn) * 64 + 16 * mt + 4 * lq); gln = gch[(nn) * 64 + 63]; } while (0)
#define G2_STORE(bufoff) do { \
            _Pragma("unroll") for (int k = 0; k < 7; ++k) { const int pid = tid + 512 * k; int off; \
                if (k < 2) off = OFF_W + ((pid >> 4) * 136 + (pid & 15) * 8) * 2; \
                else if (k < 4) off = OFF_Q + (((pid - 1024) >> 4) * 136 + ((pid - 1024) & 15) * 8) * 2; \
                else if (k < 6) off = OFF_K + (((pid - 2048) >> 3) * 72 + ((pid - 2048) & 7) * 8) * 2; \
                else off = OFF_QK + (((pid - 3072) >> 3) * 72 + ((pid - 3072) & 7) * 8) * 2; \
                *(LAS u32x4*)(lds + (bufoff) + off) = R[k]; } } while (0)
        G2_LOAD(0);
        G2_STORE(0);
        float uc[4]; f32x4 gcc = gcn; float glc = gln;
#pragma unroll
        for (int r = 0; r < 4; ++r) uc[r] = bf2f(un[r]);
        __syncthreads();
        for (int n = 0; n < 256; ++n) {
            const int bo = (n & 1) * BUFSZ;
            if (n + 1 < 256) G2_LOAD(n + 1);
            f32x4 acc = {0.f, 0.f, 0.f, 0.f};
            {
                LAS const unsigned char* Ab = lds + bo + (w < 4 ? OFF_W : OFF_Q) + ((16 * mt + l15) * 136 + 8 * lq) * 2;
                LAS const unsigned char* Bb = lds + OFF_ST + (l15 * 136 + 8 * lq) * 2;
#pragma unroll
                for (int ksx = 0; ksx < 4; ++ksx) {
                    const bf16x8 a = *(LAS const bf16x8*)(Ab + ksx * 64), b = *(LAS const bf16x8*)(Bb + ksx * 64);
                    acc = __builtin_amdgcn_mfma_f32_16x16x32_bf16(a, b, acc, 0, 0, 0);
                }
            }
            if (w < 4) {
                float vn[4], vs[4];
#pragma unroll
                for (int r = 0; r < 4; ++r) { vn[r] = uc[r] - acc[r]; vs[r] = vn[r] * __expf(glc - gcc[r]); }
                u32x2 a; a[0] = pack2(vn[0], vn[1]); a[1] = pack2(vn[2], vn[3]);
                u32x2 b; b[0] = pack2(vs[0], vs[1]); b[1] = pack2(vs[2], vs[3]);
                *(LAS u32x2*)(lds + OFF_VN + (l15 * 72 + 16 * mt + 4 * lq) * 2) = a;
                *(LAS u32x2*)(lds + OFF_VS + (l15 * 72 + 16 * mt + 4 * lq) * 2) = b;
            }
            __syncthreads();
            if (w >= 4) {
                f32x4 o;
#pragma unroll
                for (int r = 0; r < 4; ++r) o[r] = __expf(gcc[r]) * acc[r];
                LAS const unsigned char* Ab = lds + bo + OFF_QK + ((16 * mt + l15) * 72 + 8 * lq) * 2;
                LAS const unsigned char* Bb = lds + OFF_VN + (l15 * 72 + 8 * lq) * 2;
#pragma unroll
                for (int ksx = 0; ksx < 2; ++ksx) {
                    const bf16x8 a = *(LAS const bf16x8*)(Ab + ksx * 64), b = *(LAS const bf16x8*)(Bb + ksx * 64);
                    o = __builtin_amdgcn_mfma_f32_16x16x32_bf16(a, b, o, 0, 0, 0);
                }
                bf16_t* op = Vb + (size_t)(n * 32 + h) * 8192 + (size_t)(16 * mt + 4 * lq) * 128 + s * 16 + l15;
                op[0] = f2bf(o[0]); op[128] = f2bf(o[1]); op[256] = f2bf(o[2]); op[384] = f2bf(o[3]);
            }
            {
                const float gf = __expf(glc);
#pragma unroll
                for (int r = 0; r < 4; ++r) Sacc[r] *= gf;
                LAS const unsigned char* Ab = lds + bo + OFF_K + ((16 * w + l15) * 72 + 8 * lq) * 2;
                LAS const unsigned char* Bb = lds + OFF_VS + (l15 * 72 + 8 * lq) * 2;
#pragma unroll
                for (int ksx = 0; ksx < 2; ++ksx) {
                    const bf16x8 a = *(LAS const bf16x8*)(Ab + ksx * 64), b = *(LAS const bf16x8*)(Bb + ksx * 64);
                    Sacc = __builtin_amdgcn_mfma_f32_16x16x32_bf16(a, b, Sacc, 0, 0, 0);
                }
                u32x2 sv; sv[0] = pack2(Sacc[0], Sacc[1]); sv[1] = pack2(Sacc[2], Sacc[3]);
                *(LAS u32x2*)(lds + OFF_ST + (l15 * 136 + 16 * w + 4 * lq) * 2) = sv;
            }
            if (n + 1 < 256) {
                G2_STORE(((n + 1) & 1) * BUFSZ);
#pragma unroll
                for (int r = 0; r < 4; ++r) uc[r] = bf2f(un[r]);
                gcc = gcn; glc = gln;
            }
            __syncthreads();
        }
#undef G2_LOAD
#undef G2_STORE
    }
}

__device__ __forceinline__ void gdn_g3(const float* __restrict__ norm_g, const bf16_t* __restrict__ Ob, bf16_t* Z) {
    const int lane = threadIdx.x & 63, sub = lane & 15, gw = blockIdx.x * 8 + (threadIdx.x >> 6), nw = gridDim.x * 8;
    float ng[8];
#pragma unroll
    for (int k = 0; k < 8; ++k) ng[k] = norm_g[sub * 8 + k];
    for (int pi = gw * 4 + (lane >> 4); pi < T * 32; pi += nw * 4) {
        const int t = pi >> 5, h = pi & 31;
        float o[8], z[8], r[8];
        unpack8(*(const u32x4*)(Ob + ((size_t)((t >> 6) * 32 + h) * 64 + (t & 63)) * 128 + sub * 8), o);
        bf16_t* zp = Z + (size_t)t * 4096 + h * 128 + sub * 8;
        unpack8(*(const u32x4*)zp, z);
        float ss = 0.f;
#pragma unroll
        for (int k = 0; k < 8; ++k) ss += o[k] * o[k];
        ss += __shfl_xor(ss, 1); ss += __shfl_xor(ss, 2); ss += __shfl_xor(ss, 4); ss += __shfl_xor(ss, 8);
        const float rs = rsqrtf(ss * (1.0f / 128.0f) + 1e-6f);
#pragma unroll
        for (int k = 0; k < 8; ++k) r[k] = o[k] * rs * ng[k] * siluf(z[k]);
        *(u32x4*)zp = pack8(r);
    }
}
__device__ __forceinline__ void dsa_kiln(const float* __restrict__ ki, const float* __restrict__ g, const float* __restrict__ b, bf16_t* out) {
    const int lane = threadIdx.x & 63, gw = blockIdx.x * 8 + (threadIdx.x >> 6), nw = gridDim.x * 8;
    const float g0 = g[lane * 2], g1 = g[lane * 2 + 1], b0 = b[lane * 2], b1 = b[lane * 2 + 1];
    for (int row = gw; row < T; row += nw) {
        const float2 v = *(const float2*)(ki + (size_t)row * 128 + lane * 2);
        const float mean = wave_sum(v.x + v.y) * (1.0f / 128.0f);
        const float d0 = v.x - mean, d1 = v.y - mean;
        const float var = wave_sum(d0 * d0 + d1 * d1) * (1.0f / 128.0f);
        const float rstd = rsqrtf(var + 1e-5f);
        *(unsigned*)(out + (size_t)row * 128 + lane * 2) = pack2(d0 * rstd * g0 + b0, d1 * rstd * g1 + b1);
    }
}
__device__ __forceinline__ unsigned ord_key(float f) { const unsigned u = __float_as_uint(f); return (u & 0x80000000u) ? ~u : (u | 0x80000000u); }
__device__ __forceinline__ int rel_bucket(int d) {
    if (d < 16) return d;
    const float v = logf((float)d / 16.0f) / 2.0794415416798357f * 16.0f;
    const int l = 16 + (int)v; return l < 31 ? l : 31;
}
__device__ __forceinline__ int radix_pick(LAS unsigned* hist, int nb, int lane, int& kth) {
    const int per = nb >> 6, base = lane * per;
    int tot = 0;
    for (int b = 0; b < per; ++b) tot += (int)hist[base + b];
    int v = tot;
#pragma unroll
    for (int off = 1; off < 64; off <<= 1) { const int t = __shfl_down(v, off); if (lane + off < 64) v += t; }
    const int excl = v - tot;
    const bool mine = (excl < kth) && (v >= kth);
    int dsel = 0, ksel = 0, c = excl; bool found = false;
    for (int b = per - 1; b >= 0; --b) { const int hv = (int)hist[base + b]; if (mine && !found && c + hv >= kth) { dsel = base + b; ksel = kth - c; found = true; } c += hv; }
    const unsigned long long m = __ballot(mine);
    const int src = (m == 0ull) ? 0 : (__ffsll((long long)m) - 1);
    dsel = __shfl(dsel, src); ksel = __shfl(ksel, src);
    kth = ksel; return dsel;
}

__device__ __forceinline__ void dsa_phase(const bf16_t* __restrict__ qi, const bf16_t* __restrict__ kib, const float* __restrict__ wi, bf16_t* q1, const bf16_t* __restrict__ k1, const bf16_t* __restrict__ v1,
                                          float* scratch, const float* __restrict__ rel_bias, LAS unsigned char* lds) {
    int tid_ = threadIdx.x; asm volatile("" : "+v"(tid_)); const int tid = tid_, lane = tid & 63, w = tid >> 6;
    LAS bf16_t* kit = (LAS bf16_t*)lds;
    LAS unsigned* hist = (LAS unsigned*)(lds + 34816) + w * 2048;
    LAS float* qf = (LAS float*)(lds + 34816) + w * 2048;
    LAS float* pl = (LAS float*)(lds + 34816 + 65536) + w * 1024;
    LAS int* sel = (LAS int*)(lds + 34816 + 65536 + 32768);
    float* sc = scratch + (size_t)blockIdx.x * 16 * T;
    const int lh = lane >> 5, l31 = lane & 31;
    for (int kk = blockIdx.x; kk < 512; kk += gridDim.x)
        for (int half = 0; half < 2; ++half) {
            const int unit = half ? 1023 - kk : kk, t0 = unit * 16;
            if (t0 >= 256) {
                bf16x8 af[8]; float wv[16];
                {
                    const int tq = t0 + 2 * w + (l31 >> 4), hd = l31 & 15;
                    const bf16_t* ap = qi + (size_t)tq * 2048 + hd * 128 + 8 * lh;
#pragma unroll
                    for (int ksx = 0; ksx < 8; ++ksx) af[ksx] = *(const bf16x8*)(ap + ksx * 16);
#pragma unroll
                    for (int r = 0; r < 16; ++r) wv[r] = wi[(size_t)(t0 + 2 * w + (r >> 3)) * 16 + (r & 3) + 8 * ((r >> 2) & 1) + 4 * lh];
                }
                const int tqo = t0 + 2 * w + lh;
                float* srow = sc + (size_t)(2 * w + lh) * T;
                const int ntile = (t0 + 16 + 127) >> 7;
                for (int kt = 0; kt < ntile; ++kt) {
                    __syncthreads();
#pragma unroll
                    for (int i = 0; i < 4; ++i) { const int pid = tid + 512 * i, row = pid >> 4, c8 = pid & 15;
                        *(LAS u32x4*)(kit + row * 136 + c8 * 8) = *(const u32x4*)(kib + (size_t)(kt * 128 + row) * 128 + c8 * 8); }
                    __syncthreads();
#pragma unroll
                    for (int nb = 0; nb < 4; ++nb) {
                        f32x16 acc;
#pragma unroll
                        for (int r = 0; r < 16; ++r) acc[r] = 0.f;
                        LAS const bf16_t* bp = kit + (nb * 32 + l31) * 136 + 8 * lh;
#pragma unroll
                        for (int ksx = 0; ksx < 8; ++ksx) { const bf16x8 b = *(LAS const bf16x8*)(bp + ksx * 16); acc = __builtin_amdgcn_mfma_f32_32x32x16_bf16(af[ksx], b, acc, 0, 0, 0); }
                        float s0 = 0.f, s1 = 0.f;
#pragma unroll
                        for (int r = 0; r < 8; ++r) { s0 += wv[r] * fmaxf(acc[r], 0.f); s1 += wv[8 + r] * fmaxf(acc[8 + r], 0.f); }
                        const float snd = lh ? s0 : s1, rcv = __shfl_xor(snd, 32), tot = (lh ? s1 : s0) + rcv;
                        const int key = kt * 128 + nb * 32 + l31;
                        if (key <= tqo) srow[key] = tot;
                    }
                }
            }
            __threadfence();
            __syncthreads();
            for (int qq = 0; qq < 2; ++qq) {
                const int ql = 2 * w + qq, t = t0 + ql, nk = t + 1;
                LAS int* selq = sel + ql * 256;
                int nsel;
                if (nk <= 256) { for (int s = lane; s < nk; s += 64) selq[s] = s; nsel = nk; }
                else {
                    const float* srow = sc + (size_t)ql * T;
                    int kth = 256; unsigned d0, d1, d2;
                    for (int b = lane; b < 2048; b += 64) hist[b] = 0u;
                    wave_sync();
                    for (int key = lane; key < nk; key += 64) { const unsigned u = ord_key(srow[key]); __hip_atomic_fetch_add(&hist[u >> 21], 1u, __ATOMIC_RELAXED, __HIP_MEMORY_SCOPE_WORKGROUP); }
                    wave_sync();
                    d0 = (unsigned)radix_pick(hist, 2048, lane, kth);
                    wave_sync();
                    for (int b = lane; b < 2048; b += 64) hist[b] = 0u;
                    wave_sync();
                    for (int key = lane; key < nk; key += 64) { const unsigned u = ord_key(srow[key]); if ((u >> 21) == d0) __hip_atomic_fetch_add(&hist[(u >> 10) & 2047u], 1u, __ATOMIC_RELAXED, __HIP_MEMORY_SCOPE_WORKGROUP); }
                    wave_sync();
                    d1 = (unsigned)radix_pick(hist, 2048, lane, kth);
                    wave_sync();
                    for (int b = lane; b < 1024; b += 64) hist[b] = 0u;
                    wave_sync();
                    const unsigned pre = (d0 << 11) | d1;
                    for (int key = lane; key < nk; key += 64) { const unsigned u = ord_key(srow[key]); if ((u >> 10) == pre) __hip_atomic_fetch_add(&hist[u & 1023u], 1u, __ATOMIC_RELAXED, __HIP_MEMORY_SCOPE_WORKGROUP); }
                    wave_sync();
                    d2 = (unsigned)radix_pick(hist, 1024, lane, kth);
                    wave_sync();
                    const unsigned tau = (pre << 10) | d2;
                    int cnt = 0, eqleft = kth;
                    const unsigned long long ltmask = (lane == 0) ? 0ull : (~0ull >> (64 - lane));
                    for (int key0 = 0; key0 < nk; key0 += 64) {
                        const int key = key0 + lane; const bool in = key < nk;
                        const unsigned u = in ? ord_key(srow[key]) : 0u;
                        const bool gt = in && (u > tau), eq = in && (u == tau);
                        const unsigned long long meq = __ballot(eq);
                        const bool take = gt || (eq && (__popcll(meq & ltmask) < eqleft));
                        const unsigned long long mt = __ballot(take);
                        const int pos = cnt + __popcll(mt & ltmask);
                        if (take && pos < 256) selq[pos] = key;
                        cnt += __popcll(mt);
                        const int neq = __popcll(meq); eqleft -= (neq < eqleft ? neq : eqleft);
                    }
                    nsel = 256;
                }
                wave_sync();
                {
#pragma unroll
                    for (int i = 0; i < 4; ++i) { const int pc = lane + 64 * i; float f[8]; unpack8(*(const u32x4*)(q1 + (size_t)t * 2048 + pc * 8), f);
#pragma unroll
                        for (int e = 0; e < 8; ++e) qf[pc * 8 + e] = f[e]; }
                }
                wave_sync();
                for (int g = 0; g < 4; ++g) {
                    float lg[4][4];
#pragma unroll
                    for (int r = 0; r < 4; ++r) {
                        const int s = r * 64 + lane; const bool valid = s < nsel;
                        const int idx = valid ? selq[s] : 0;
                        float a[4] = {0.f, 0.f, 0.f, 0.f};
                        if (r * 64 < nsel) {
                            const bf16_t* kr = k1 + (size_t)idx * 512 + g * 128;
#pragma unroll 4
                            for (int c = 0; c < 16; ++c) {
                                float kf[8]; unpack8(*(const u32x4*)(kr + c * 8), kf);
#pragma unroll
                                for (int hl = 0; hl < 4; ++hl) {
                                    const f32x4 q0 = *(LAS const f32x4*)(qf + (4 * g + hl) * 128 + c * 8), q4 = *(LAS const f32x4*)(qf + (4 * g + hl) * 128 + c * 8 + 4);
                                    a[hl] += kf[0] * q0[0] + kf[1] * q0[1] + kf[2] * q0[2] + kf[3] * q0[3] + kf[4] * q4[0] + kf[5] * q4[1] + kf[6] * q4[2] + kf[7] * q4[3];
                                }
                            }
                        }
                        const int bk = rel_bucket(t - idx);
#pragma unroll
                        for (int hl = 0; hl < 4; ++hl) lg[r][hl] = valid ? a[hl] * 0.08838834764831845f + rel_bias[bk * 16 + 4 * g + hl] : -INFINITY;
                    }
#pragma unroll
                    for (int hl = 0; hl < 4; ++hl) {
                        float m = fmaxf(fmaxf(lg[0][hl], lg[1][hl]), fmaxf(lg[2][hl], lg[3][hl])); m = wave_max(m);
                        float e[4], sum = 0.f;
#pragma unroll
                        for (int r = 0; r < 4; ++r) { e[r] = __expf(lg[r][hl] - m); sum += e[r]; }
                        sum = wave_sum(sum); const float inv = 1.0f / sum;
#pragma unroll
                        for (int r = 0; r < 4; ++r) pl[(r * 64 + lane) * 4 + hl] = e[r] * inv;
                    }
                    wave_sync();
                    float o[4][2];
#pragma unroll
                    for (int hl = 0; hl < 4; ++hl) { o[hl][0] = 0.f; o[hl][1] = 0.f; }
                    const bf16_t* vb = v1 + g * 128 + lane * 2;
#pragma unroll 4
                    for (int s = 0; s < nsel; ++s) {
                        const int idx = selq[s];
                        const unsigned vv = *(const unsigned*)(vb + (size_t)idx * 512);
                        const f32x4 p4 = *(LAS const f32x4*)(pl + s * 4);
                        const float vlo = bflo(vv), vhi = bfhi(vv);
#pragma unroll
                        for (int hl = 0; hl < 4; ++hl) { o[hl][0] += p4[hl] * vlo; o[hl][1] += p4[hl] * vhi; }
                    }
#pragma unroll
                    for (int hl = 0; hl < 4; ++hl) *(unsigned*)(q1 + (size_t)t * 2048 + (4 * g + hl) * 128 + lane * 2) = pack2(o[hl][0], o[hl][1]);
                    wave_sync();
                }
            }
            __syncthreads();
        }
}
#ifndef MIXER_STAGE
#define MIXER_STAGE 2
#endif
__device__ __forceinline__ void zero_fill(bf16_t* p, size_t n8) {
    u32x4 z; z.x = z.y = z.z = z.w = 0u;
    for (size_t i = (size_t)blockIdx.x * 512 + threadIdx.x; i < n8; i += (size_t)gridDim.x * 512) ((u32x4*)p)[i] = z;
}

#define WSB(m) ((bf16_t*)(ws + (size_t)(m) * MiB))
#define WSF(m) ((float*)(ws + (size_t)(m) * MiB))
#define GSYNC() do { __threadfence(); grid.sync(); } while (0)
template <int L> __device__ __forceinline__ void layer_body(const KP& p, unsigned char* ws, LAS unsigned char* lds, cg::grid_group& grid, int& tb) {
        constexpr int oA_o = L ? 49 : 369, Ko = L ? 2048 : 4096, oWo = L ? 21 : 113, oY1 = 241, oX1 = L ? 113 : 49;
        constexpr int oWgu = L ? 497 : 129, oG = L ? 177 : 241, oU = L ? 337 : 401, oWd = L ? 537 : 169, oY2 = L ? 177 : 241, oX2 = 49;
        constexpr int oPb = L ? 38 : 593, oWpp = L ? 37 : 197, oPP = L ? 305 : 369, oWpg = L ? 29 : 189;
        if constexpr (L == 0) {
            { EpiRoute e = mkroute(); e.nseg = 4;
              e.seg[0] = mkseg(WSB(113), 8, 2 * 8192, 16 * 8192, 128, 8192);
              e.seg[1] = mkseg(WSB(177), 16, 2 * 8192, 16 * 8192, 128, 8192);
              e.seg[2] = mkseg(WSB(241), 32, 2 * 8192, 32 * 8192, 128, 8192);
              e.seg[3] = mkseg(WSB(369), 48, 256, 64 * 4096, 4096, 128);
              e.halo = WSB(581); e.halo_pn = 32; e.fpn = 48;
              e.ft0.ptr = WSF(577); e.ft0.lc0 = 0; e.ft0.lc1 = 64; e.ft0.ld = 64; e.ft0.scale = 1.f;
              run_gemm(lds, WSB(49), WSB(0), 12544, 2048, e); }
            GSYNC();
#if MIXER_STAGE >= 1
            gdn_g1(p, ws, lds);
            GSYNC();
            gdn_g2(ws, lds);
            GSYNC();
            gdn_g3(p.in[6], WSB(241), WSB(369));
#else
            zero_fill(WSB(369), (size_t)T * 4096 / 8);
#endif
            convT_tiles(p.in[7], 4096, 2048, 2048, WSB(113), (LAS float*)lds, tb);
            convT_tiles(p.in[15], 2048, 5120, 5120, WSB(129), (LAS float*)lds, tb);
            convT_tiles(p.in[16], 2048, 5120, 5120, WSB(149), (LAS float*)lds, tb);
            convT_tiles(p.in[18], 5120, 2048, 2048, WSB(169), (LAS float*)lds, tb);
            convT_tiles(p.in[22], 2048, 2048, 2048, WSB(189), (LAS float*)lds, tb);
            convT_tiles(p.in[21], 256, 2048, 2048, WSB(197), (LAS float*)lds, tb);
            cvt_bf16(p.in[1], WSB(593), (size_t)T * 256 / 8);
            GSYNC();
        } else {
            { EpiRoute e = mkroute(); e.nseg = 4;
              e.seg[0] = mkseg(WSB(49), 8, 256, 64 * 2048, 2048, 128);
              e.seg[1] = mkseg(WSB(177), 10, 256, 64 * 512, 512, 128);
              e.seg[2] = mkseg(WSB(193), 12, 256, 64 * 512, 512, 128);
              e.seg[3] = mkseg(WSB(113), 20, 256, 64 * 2048, 2048, 128);
              e.fpn = 20;
              e.ft0.ptr = WSF(209); e.ft0.lc0 = 0; e.ft0.lc1 = 128; e.ft0.ld = 128; e.ft0.scale = 1.f;
              e.ft1.ptr = WSF(221); e.ft1.lc0 = 128; e.ft1.lc1 = 144; e.ft1.ld = 16; e.ft1.scale = 0.022097086912079608f;
              run_gemm(lds, WSB(557), WSB(0), 5376, 2048, e); }
            GSYNC();
#if MIXER_STAGE >= 2
            dsa_kiln(WSF(209), p.in[9], p.in[10], WSB(217));
            GSYNC();
            dsa_phase(WSB(113), WSB(217), WSF(221), WSB(49), WSB(177), WSB(193), WSF(241), p.in[12], lds);
#else
            zero_fill(WSB(49), (size_t)T * 2048 / 8);
#endif
            GSYNC();
        }
        { EpiResid f; f.rf = L ? nullptr : p.in[0]; f.rb = L ? WSB(557) : nullptr; f.Y = WSF(oY1);
          run_gemm(lds, WSB(oA_o), WSB(oWo), 2048, Ko, f); }
        GSYNC();
        ln_phase(WSF(oY1), p.in[13] + L * 2048, p.in[14] + L * 2048, WSB(oX1), false);
        GSYNC();
        { EpiRoute e = mkroute(); e.nseg = 2;
          e.seg[0] = mkseg(WSB(oG), 20, 256, 64 * 5120, 5120, 128); e.seg[1] = mkseg(WSB(oU), 40, 256, 64 * 5120, 5120, 128);
          run_gemm(lds, WSB(oX1), WSB(oWgu), 10240, 2048, e); }
        GSYNC();
        convglu_phase(WSB(oG), WSB(oU), p.in[17] + (size_t)L * 3 * 5120);
        GSYNC();
        { EpiResid f; f.rf = nullptr; f.rb = WSB(oX1); f.Y = WSF(oY2); run_gemm(lds, WSB(oU), WSB(oWd), 2048, 5120, f); }
        GSYNC();
        ln_phase(WSF(oY2), p.in[19] + L * 2048, p.in[20] + L * 2048, WSB(oX2), true);
        if constexpr (L == 0) {
            convT_tiles(p.in[8], 2048, 5264, 5376, WSB(0), (LAS float*)lds, tb);
            convT_tiles(p.in[11], 2048, 2048, 2048, WSB(21), (LAS float*)lds, tb);
            convT_tiles(p.in[22] + (size_t)2048 * 2048, 2048, 2048, 2048, WSB(29), (LAS float*)lds, tb);
            convT_tiles(p.in[21] + (size_t)256 * 2048, 256, 2048, 2048, WSB(37), (LAS float*)lds, tb);
            cvt_bf16(p.in[1] + (size_t)T * 256, WSB(38), (size_t)T * 256 / 8);
            convT_tiles(p.in[15] + (size_t)2048 * 5120, 2048, 5120, 5120, WSB(497), (LAS float*)lds, tb);
            convT_tiles(p.in[16] + (size_t)2048 * 5120, 2048, 5120, 5120, WSB(517), (LAS float*)lds, tb);
            convT_tiles(p.in[18] + (size_t)5120 * 2048, 5120, 2048, 2048, WSB(537), (LAS float*)lds, tb);
        }
        GSYNC();
        { EpiRoute e = mkroute(); e.nseg = 1; e.seg[0] = mkseg(WSB(oPP), 8, 256, 64 * 2048, 2048, 128);
          int Kpp = 256; asm volatile("" : "+s"(Kpp));
          run_gemm(lds, WSB(oPb), WSB(oWpp), 2048, Kpp, e); }
        GSYNC();
        { EpiPle f; f.x2 = WSF(oY2); f.PP = WSB(oPP); f.xb = L ? nullptr : WSB(557); f.fo = p.out;
          run_gemm(lds, WSB(oX2), WSB(oWpg), 2048, 2048, f); }
        GSYNC();
}

__global__ void __launch_bounds__(512, 2) fwd_kernel(KP p) {
    extern __shared__ __attribute__((aligned(16))) unsigned char lds_raw[];
    LAS unsigned char* lds = (LAS unsigned char*)lds_raw;
    cg::grid_group grid = cg::this_grid();
    unsigned char* ws = p.ws;
    int tb = 0;
    convT_tiles(p.in[2], 2048, 12352, 12544, WSB(0), (LAS float*)lds, tb);
    cvt_bf16(p.in[0], WSB(49), (size_t)T * 2048 / 8);
    GSYNC();
    layer_body<0>(p, ws, lds, grid, tb);
    layer_body<1>(p, ws, lds, grid, tb);
}

extern "C" void kernel_launch(void* const* d_in, const int* in_sizes, int n_in, void* d_out, int out_size, void* d_ws, size_t ws_size, hipStream_t stream) {
    static int grid = 0;
    if (grid == 0) {
        if (n_in != 23 || out_size != T * DM || ws_size < 621 * MiB) { fprintf(stderr, "kernel_launch: unexpected problem (n_in %d, out %d, ws %zu); nothing launched\n", n_in, out_size, ws_size); grid = -1; return; }
        int dev = 0, cus = 0, per_cu = 0;
        hipGetDevice(&dev); hipDeviceGetAttribute(&cus, hipDeviceAttributeMultiprocessorCount, dev);
        if (hipFuncSetAttribute((const void*)fwd_kernel, hipFuncAttributeMaxDynamicSharedMemorySize, LDS_BYTES) != hipSuccess) { fprintf(stderr, "kernel_launch: hipFuncSetAttribute failed\n"); grid = -1; return; }
        if (hipOccupancyMaxActiveBlocksPerMultiprocessor(&per_cu, (const void*)fwd_kernel, 512, LDS_BYTES) != hipSuccess || per_cu < 1) { fprintf(stderr, "kernel_launch: occupancy query says %d\n", per_cu); per_cu = 1; }
        (void)hipGetLastError();
        grid = cus;
        if (grid > 256) grid = 256;
    }
    if (grid < 0) return;
    KP p{};
    for (int i = 0; i < 23; ++i) p.in[i] = (const float*)d_in[i];
    p.out = (float*)d_out; p.ws = (unsigned char*)d_ws;
    void* args[] = {&p};
    hipError_t e = hipLaunchCooperativeKernel((const void*)fwd_kernel, dim3(grid), dim3(512), args, LDS_BYTES, stream);
    if (e != hipSuccess) fprintf(stderr, "cooperative launch failed: %s (grid %d)\n", hipGetErrorString(e), grid);
}
```

```cpp
#include <hip/hip_runtime.h>
#include <hip/hip_cooperative_groups.h>
#include <cstdio>
namespace cg = cooperative_groups;
#define MIXER_STAGE 2
__device__ __forceinline__ int tid_op(int kwid);
namespace pg8 {
#define PG8_LAS __attribute__((address_space(3)))
typedef unsigned short bf16_t;
typedef short bf16x8 __attribute__((ext_vector_type(8)));
typedef float f32x4 __attribute__((ext_vector_type(4)));
typedef unsigned u32x4 __attribute__((ext_vector_type(4)));
constexpr int BM = 256, BK = 64, HALF = 128, HTB = HALF * BK * 2  , STAGE_BYTES = 8 * HTB, NXCD = 8, WGM = 8;

__host__ __device__ __forceinline__ int lds_byte(int r, int c) { const int st = (r >> 4) * 2 + (c >> 5), rr = r & 15, cc = c & 31, ob = rr * 64 + cc * 2; return st * 1024 + (ob ^ (((ob >> 9) & 1) << 5)); }
__host__ __device__ __forceinline__ void stage_rc(int b, int& R, int& C) { const int st = b / 1024, sb = b % 1024, swz = sb ^ (((sb >> 9) & 1) << 5); R = (st >> 1) * 16 + swz / 64; C = (st & 1) * 32 + (swz % 64) / 2; }
__host__ __device__ __forceinline__ int perm32(int rho) { const int n = rho >> 4, i = rho & 15; return 8 * (i >> 2) + 4 * n + (i & 3); }

struct Unit { int pm, pn; };
struct Gemm { const bf16_t* A; const bf16_t* Bt; int M, N, K; };

struct StaticOrder {
    int nM, nN, nwg, G, c;
    __host__ __device__ void init(int M, int N, int G_, int c_) { nM = M / BM; nN = N / BM; nwg = nM * nN; G = G_; c = c_; }
    __host__ __device__ bool next(int i, Unit& u) const {
        const long L = (long)i * G + c; if (L >= nwg) return false;
        int wgid = (int)L; { const int q = nwg / NXCD, r = nwg % NXCD, xcd = wgid % NXCD, off = wgid / NXCD; wgid = (xcd < r ? xcd * (q + 1) : r * (q + 1) + (xcd - r) * q) + off; }
        const int nig = WGM * nN, gid = wgid / nig, fm = gid * WGM, gsz = (nM - fm) < WGM ? (nM - fm) : WGM;
        u.pm = fm + ((wgid % nig) % gsz); u.pn = (wgid % nig) / gsz; return true;
    }
    __device__ __forceinline__ void a_ready(const Unit&) const {}
    __device__ __forceinline__ void done(const Unit&) const {}
};
template <class Epi, class Sched, bool STAMP = false>
__device__ __forceinline__ void gemm_phase(PG8_LAS unsigned char* lds, const Gemm g, const Sched& S, const Epi& E, unsigned long long* stamps, const int kwid) {
    const int tid = tid_op(kwid), wid = __builtin_amdgcn_readfirstlane(tid >> 6), lane = tid & 63, wr = wid >> 2, wc = wid & 3, fr = lane & 15, fq = lane >> 4;
    const int K = g.K, nt = K / BK;
    int ts_lo = 0, ts_hi = 0, nts = 0; const unsigned long long rt_entry = STAMP ? (unsigned long long)wall_clock64() : 0ull;
#define PG8_STAMP() do { if (STAMP && wid == 0 && nts < 64) { const unsigned long long _c = (unsigned long long)clock64(); \
        ts_lo = (lane == nts) ? (int)(unsigned)_c : ts_lo; ts_hi = (lane == nts) ? (int)(unsigned)(_c >> 32) : ts_hi; ++nts; } } while (0)
    PG8_STAMP();
    unsigned voffA[2], voffB[2];
#pragma unroll
    for (int i = 0; i < 2; ++i) { int R, C; stage_rc(tid * 16 + i * 8192, R, C); const int Rb = Epi::PERM ? ((R & ~31) + perm32(R & 31)) : R;
        voffA[i] = (unsigned)(R * K + C) * 2u; voffB[i] = (unsigned)(Rb * K + C) * 2u; }
    const size_t kstep = (size_t)(BK * 2);
    const size_t hstep = (size_t)HALF * K * 2;
    const size_t tstep = 2 * hstep;
    const unsigned ldsw = (unsigned)wid * 1024u;
    const int aoff = lds_byte(wr * 64 + fr, fq * 8), boff = lds_byte(wc * 32 + fr, fq * 8);
#define PG8_SA(b, h) (((b) * 2 + (h)) * HTB)
#define PG8_SB(b, h) ((4 + (b) * 2 + (h)) * HTB)
#define PG8_STAGE(bufoff, gbase, voff) do { _Pragma("unroll") for (int _i = 0; _i < 2; ++_i) \
        __builtin_amdgcn_global_load_lds((const unsigned*)((const char*)(gbase) + (voff)[_i]), (PG8_LAS unsigned*)(lds + (bufoff) + ldsw + _i * 8192), 16, 0, 0); } while (0)
#define PG8_LDA(dst, b, h) do { _Pragma("unroll") for (int m = 0; m < 4; ++m) _Pragma("unroll") for (int k = 0; k < 2; ++k) dst[m][k] = *(const PG8_LAS bf16x8*)(lds + PG8_SA(b, h) + aoff + m * 2048 + k * 1024); } while (0)
#define PG8_LDB(dst, b, h) do { _Pragma("unroll") for (int n = 0; n < 2; ++n) _Pragma("unroll") for (int k = 0; k < 2; ++k) dst[n][k] = *(const PG8_LAS bf16x8*)(lds + PG8_SB(b, h) + boff + n * 2048 + k * 1024); } while (0)
#define PG8_MMA(ai, bj, At, Bt) do { __builtin_amdgcn_s_setprio(1); _Pragma("unroll") for (int m = 0; m < 4; ++m) _Pragma("unroll") for (int n = 0; n < 2; ++n) _Pragma("unroll") for (int k = 0; k < 2; ++k) \
        acc[ai][bj][m][n] = __builtin_amdgcn_mfma_f32_16x16x32_bf16(Bt[n][k], At[m][k], acc[ai][bj][m][n], 0, 0, 0); __builtin_amdgcn_s_setprio(0); } while (0)
#define PG8_WAIT_V(n) asm volatile("s_waitcnt vmcnt(" #n ")" ::: "memory")
#define PG8_WAIT_L(n) asm volatile("s_waitcnt lgkmcnt(" #n ")" ::: "memory")
#define PG8_BAR __builtin_amdgcn_s_barrier()
#define PG8_SCHED __builtin_amdgcn_sched_barrier(0)
    Unit cur, nxt; int ui = 0;
    if (!S.next(0, cur)) return;
    f32x4 acc[2][2][4][2];
#pragma unroll
    for (int a = 0; a < 2; ++a)
#pragma unroll
        for (int b = 0; b < 2; ++b)
#pragma unroll
            for (int m = 0; m < 4; ++m)
#pragma unroll
                for (int n = 0; n < 2; ++n) acc[a][b][m][n] = (f32x4){0.f, 0.f, 0.f, 0.f};
    bf16x8 At[4][2], B0[2][2], B1[2][2];
    const char* cA = (const char*)g.A + (size_t)cur.pm * tstep; const char* cB = (const char*)g.Bt + (size_t)cur.pn * tstep;
    S.a_ready(cur);
    PG8_STAGE(PG8_SB(0, 0), cB, voffB); PG8_STAGE(PG8_SA(0, 0), cA, voffA); PG8_STAGE(PG8_SB(0, 1), cB + hstep, voffB); PG8_STAGE(PG8_SA(0, 1), cA + hstep, voffA);
    if (wr == 1) PG8_BAR;
    PG8_WAIT_V(4); PG8_BAR;
    PG8_STAGE(PG8_SB(1, 0), cB + kstep, voffB); PG8_STAGE(PG8_SA(1, 0), cA + kstep, voffA); PG8_STAGE(PG8_SB(1, 1), cB + hstep + kstep, voffB);
    PG8_WAIT_V(6); PG8_BAR;
    PG8_STAMP();
    for (;;) {
        const bool has_next = S.next(ui + 1, nxt);
        const char* nA = has_next ? (const char*)g.A + (size_t)nxt.pm * tstep : cA; const char* nB = has_next ? (const char*)g.Bt + (size_t)nxt.pn * tstep : cB;
        for (int t = 0; t < nt; t += 2) {
            const bool last = (t == nt - 2);
            const char* a1 = cA + (size_t)(t + 1) * kstep;
            const char* a2 = last ? nA : cA + (size_t)(t + 2) * kstep; const char* b2 = last ? nB : cB + (size_t)(t + 2) * kstep;
            const char* a3 = a2 + kstep; const char* b3 = b2 + kstep;
            if (last && has_next) S.a_ready(nxt);
            PG8_LDB(B0, 0, 0); PG8_SCHED; PG8_LDA(At, 0, 0); PG8_STAGE(PG8_SA(1, 1), a1 + hstep, voffA);
            PG8_WAIT_L(8); PG8_BAR; PG8_WAIT_L(0); PG8_MMA(0, 0, At, B0); PG8_BAR; PG8_SCHED;
            PG8_LDB(B1, 0, 1); PG8_STAGE(PG8_SB(0, 0), b2, voffB);
            PG8_BAR; PG8_WAIT_L(0); PG8_MMA(0, 1, At, B1); PG8_BAR;
            PG8_LDA(At, 0, 1); PG8_STAGE(PG8_SA(0, 0), a2, voffA);
            PG8_BAR; PG8_WAIT_L(0); PG8_MMA(1, 0, At, B0); PG8_BAR; PG8_SCHED;
            PG8_STAGE(PG8_SB(0, 1), b2 + hstep, voffB);
            PG8_WAIT_V(6); PG8_BAR; PG8_MMA(1, 1, At, B1); PG8_BAR;
            PG8_LDB(B0, 1, 0); PG8_SCHED; PG8_LDA(At, 1, 0); PG8_STAGE(PG8_SA(0, 1), a2 + hstep, voffA);
            PG8_WAIT_L(8); PG8_BAR; PG8_WAIT_L(0); PG8_MMA(0, 0, At, B0); PG8_BAR; PG8_SCHED;
            PG8_LDB(B1, 1, 1); PG8_STAGE(PG8_SB(1, 0), b3, voffB);
            PG8_BAR; PG8_WAIT_L(0); PG8_MMA(0, 1, At, B1); PG8_BAR;
            PG8_LDA(At, 1, 1); PG8_STAGE(PG8_SA(1, 0), a3, voffA);
            PG8_BAR; PG8_WAIT_L(0); PG8_MMA(1, 0, At, B0); PG8_BAR; PG8_SCHED;
            PG8_STAGE(PG8_SB(1, 1), b3 + hstep, voffB);
            PG8_WAIT_V(6); PG8_BAR; PG8_MMA(1, 1, At, B1); PG8_BAR;
        }
        PG8_STAMP();
        if constexpr (!Epi::AFTER_DRAIN) { E(acc, cur, wr, wc, fr, fq); S.done(cur); }
        PG8_STAMP();
        if (!has_next) break;
#pragma unroll
        for (int a = 0; a < 2; ++a)
#pragma unroll
            for (int b = 0; b < 2; ++b)
#pragma unroll
                for (int m = 0; m < 4; ++m)
#pragma unroll
                    for (int n = 0; n < 2; ++n) acc[a][b][m][n] = (f32x4){0.f, 0.f, 0.f, 0.f};
        cur = nxt; cA = nA; cB = nB; ++ui;
    }
    PG8_WAIT_V(0);
    if (wr == 0) PG8_BAR;
    PG8_BAR;
    if constexpr (Epi::AFTER_DRAIN) { E.fused(acc, cur, wr, wc, fr, fq, lds, wid, lane); S.done(cur); }
    PG8_STAMP();
    if (STAMP && wid == 0) { stamps[lane] = lane < nts ? (((unsigned long long)(unsigned)ts_hi << 32) | (unsigned)ts_lo) : 0ull;
        if (lane == 62) stamps[62] = rt_entry; if (lane == 63) stamps[63] = (unsigned long long)wall_clock64(); }
#undef PG8_STAMP
#undef PG8_SA
#undef PG8_SB
#undef PG8_STAGE
#undef PG8_LDA
#undef PG8_LDB
#undef PG8_MMA
#undef PG8_WAIT_V
#undef PG8_WAIT_L
#undef PG8_BAR
#undef PG8_SCHED
}
}

#include <cstdio>
#include <ctime>
#include <cstdlib>
#include <cstring>
#include <cmath>
#include <vector>
#include <algorithm>
#define CK(x) do { hipError_t e_ = (x); if (e_ != hipSuccess) { fprintf(stderr, "HIP %s:%d %s\n", __FILE__, __LINE__, hipGetErrorString(e_)); exit(2); } } while (0)
using pg8::bf16_t; using pg8::bf16x8; using pg8::f32x4; using pg8::u32x4;
typedef float f32x16 __attribute__((ext_vector_type(16)));
typedef unsigned u32x2 __attribute__((ext_vector_type(2)));
#define LAS PG8_LAS
constexpr int T = 16384, DM = 2048;
constexpr size_t MiB = 1ull << 20;
constexpr int LDS_BYTES = 152576;
constexpr float DN_ALPHA = 1.4142135623730951f;

struct KP { const float* in[23]; float* out; unsigned char* ws; };

typedef float f32x2c __attribute__((ext_vector_type(2)));
typedef __bf16 bf16x2c __attribute__((ext_vector_type(2)));
__device__ __forceinline__ unsigned pack2(float lo, float hi) { const f32x2c v = {lo, hi}; return __builtin_bit_cast(unsigned, __builtin_convertvector(v, bf16x2c)); }
__device__ __forceinline__ unsigned short f2bf(float f) { return (unsigned short)(pack2(f, 0.f) & 0xffffu); }
__device__ __forceinline__ float bf2f(unsigned short b) { return __uint_as_float(((unsigned)b) << 16); }
__device__ __forceinline__ float bflo(unsigned w) { return __uint_as_float(w << 16); }
__device__ __forceinline__ float bfhi(unsigned w) { return __uint_as_float(w & 0xffff0000u); }
__device__ __forceinline__ void unpack8(const u32x4 v, float* f) { f[0] = bflo(v.x); f[1] = bfhi(v.x); f[2] = bflo(v.y); f[3] = bfhi(v.y); f[4] = bflo(v.z); f[5] = bfhi(v.z); f[6] = bflo(v.w); f[7] = bfhi(v.w); }
__device__ __forceinline__ u32x4 pack8(const float* f) { u32x4 w; w.x = pack2(f[0], f[1]); w.y = pack2(f[2], f[3]); w.z = pack2(f[4], f[5]); w.w = pack2(f[6], f[7]); return w; }
__device__ __forceinline__ float wave_sum(float v) { v += __shfl_xor(v, 32); v += __shfl_xor(v, 16); v += __shfl_xor(v, 8); v += __shfl_xor(v, 4); v += __shfl_xor(v, 2); v += __shfl_xor(v, 1); return v; }
__device__ __forceinline__ float wave_max(float v) { v = fmaxf(v, __shfl_xor(v, 32)); v = fmaxf(v, __shfl_xor(v, 16)); v = fmaxf(v, __shfl_xor(v, 8)); v = fmaxf(v, __shfl_xor(v, 4)); v = fmaxf(v, __shfl_xor(v, 2)); v = fmaxf(v, __shfl_xor(v, 1)); return v; }
__device__ __forceinline__ void wave_sync() { __builtin_amdgcn_fence(__ATOMIC_SEQ_CST, "wavefront"); __builtin_amdgcn_wave_barrier(); __builtin_amdgcn_fence(__ATOMIC_SEQ_CST, "wavefront"); }
__device__ __forceinline__ int tid_op(int kwid) {
    int l; asm volatile("v_mbcnt_lo_u32_b32 %0, -1, 0\n\tv_mbcnt_hi_u32_b32 %0, -1, %0" : "=v"(l));
    return (kwid << 6) | l; }
__device__ __forceinline__ float bperm_f(int srclane, float v) { return __int_as_float(__builtin_amdgcn_ds_bpermute(srclane << 2, __float_as_int(v))); }
__device__ __forceinline__ int bperm_i(int srclane, int v) { return __builtin_amdgcn_ds_bpermute(srclane << 2, v); }
__device__ __forceinline__ float wsum_l(float v, int ln) { v += bperm_f(ln ^ 32, v); v += bperm_f(ln ^ 16, v); v += bperm_f(ln ^ 8, v); v += bperm_f(ln ^ 4, v); v += bperm_f(ln ^ 2, v); v += bperm_f(ln ^ 1, v); return v; }
__device__ __forceinline__ float wmax_l(float v, int ln) { v = fmaxf(v, bperm_f(ln ^ 32, v)); v = fmaxf(v, bperm_f(ln ^ 16, v)); v = fmaxf(v, bperm_f(ln ^ 8, v)); v = fmaxf(v, bperm_f(ln ^ 4, v)); v = fmaxf(v, bperm_f(ln ^ 2, v)); v = fmaxf(v, bperm_f(ln ^ 1, v)); return v; }
__device__ __forceinline__ float siluf(float x) { return x * __builtin_amdgcn_rcpf(1.0f + __expf(-x)); }
__device__ __forceinline__ float sigmoidf_(float x) { return __builtin_amdgcn_rcpf(1.0f + __expf(-x)); }

__device__ __forceinline__ void convT_tiles(const float* __restrict__ in, int K, int N, int Npad, bf16_t* __restrict__ out, LAS float* tile, int& tbase, int kwid) {
    const int G = gridDim.x, tid = tid_op(kwid);
    const int ntn = Npad >> 8, ntiles = (K >> 6) * ntn;
    int first = ((int)blockIdx.x - tbase) % G; if (first < 0) first += G;
    for (int t = first; t < ntiles; t += G) {
        const int kt = t / ntn, nt = t - kt * ntn, k0 = kt << 6, n0 = nt << 8;
        float4 v[8];
#pragma unroll
        for (int i = 0; i < 8; ++i) {
            const int e = tid + i * 512, kk = e >> 6, n4 = (e & 63) << 2, n = n0 + n4;
            v[i] = make_float4(0.f, 0.f, 0.f, 0.f);
            if (n < N) v[i] = *(const float4*)(in + (size_t)(k0 + kk) * N + n);
        }
#pragma unroll
        for (int i = 0; i < 8; ++i) {
            const int e = tid + i * 512, kk = e >> 6, n4 = (e & 63) << 2;
            LAS float* d = tile + kk * 257 + n4; d[0] = v[i].x; d[1] = v[i].y; d[2] = v[i].z; d[3] = v[i].w;
        }
        __syncthreads();
#pragma unroll
        for (int i = 0; i < 4; ++i) {
            const int e = tid + i * 512, n = e >> 3, k8 = (e & 7) << 3; float f[8];
#pragma unroll
            for (int j = 0; j < 8; ++j) f[j] = tile[(k8 + j) * 257 + n];
            *(u32x4*)(out + (size_t)(n0 + n) * K + k0 + k8) = pack8(f);
        }
        __syncthreads();
    }
    tbase = (tbase + ntiles) % G;
}
__device__ __forceinline__ void cvt_bf16(const float* __restrict__ in, bf16_t* __restrict__ out, size_t n8, int kwid) {
    for (size_t i = (size_t)blockIdx.x * 512 + tid_op(kwid); i < n8; i += (size_t)gridDim.x * 512) {
        const float4 a = ((const float4*)in)[2 * i], b = ((const float4*)in)[2 * i + 1];
        u32x4 w; w.x = pack2(a.x, a.y); w.y = pack2(a.z, a.w); w.z = pack2(b.x, b.y); w.w = pack2(b.z, b.w);
        ((u32x4*)out)[i] = w;
    }
}

__device__ __forceinline__ void ln_phase(const bf16_t* Y, const float* __restrict__ g, const float* __restrict__ b, bf16_t* xb, float* xf, int kwid) {
    const int tidx = tid_op(kwid), lane = tidx & 63, gw = blockIdx.x * 8 + (tidx >> 6), nw = gridDim.x * 8;
    for (int row = gw; row < T; row += nw) {
        const u32x4* yr = (const u32x4*)(Y + (size_t)row * DM);
        float v[4][8]; float s = 0.f;
#pragma unroll
        for (int i = 0; i < 4; ++i) { unpack8(yr[i * 64 + lane], v[i]);
#pragma unroll
            for (int k = 0; k < 8; ++k) s += v[i][k]; }
        s = wave_sum(s); const float mean = s * (1.0f / 2048.0f);
        float q = 0.f;
#pragma unroll
        for (int i = 0; i < 4; ++i)
#pragma unroll
            for (int k = 0; k < 8; ++k) { const float d = v[i][k] - mean; q += d * d; }
        q = wave_sum(q); const float rstd = rsqrtf(q * (1.0f / 2048.0f) + 1e-5f);
#pragma unroll
        for (int i = 0; i < 4; ++i) {
            const int c = (i * 64 + lane) * 8; float o[8];
            const float4 g0 = *(const float4*)(g + c), g1 = *(const float4*)(g + c + 4), b0 = *(const float4*)(b + c), b1 = *(const float4*)(b + c + 4);
            o[0] = (v[i][0] - mean) * rstd * g0.x + b0.x; o[1] = (v[i][1] - mean) * rstd * g0.y + b0.y; o[2] = (v[i][2] - mean) * rstd * g0.z + b0.z; o[3] = (v[i][3] - mean) * rstd * g0.w + b0.w;
            o[4] = (v[i][4] - mean) * rstd * g1.x + b1.x; o[5] = (v[i][5] - mean) * rstd * g1.y + b1.y; o[6] = (v[i][6] - mean) * rstd * g1.z + b1.z; o[7] = (v[i][7] - mean) * rstd * g1.w + b1.w;
            *(u32x4*)(xb + (size_t)row * DM + c) = pack8(o);
            if (xf) { f32x4 f0 = {o[0], o[1], o[2], o[3]}, f1 = {o[4], o[5], o[6], o[7]}; *(f32x4*)(xf + (size_t)row * DM + c) = f0; *(f32x4*)(xf + (size_t)row * DM + c + 4) = f1; }
        }
    }
}

__device__ __forceinline__ void convglu_phase(const bf16_t* Gm, bf16_t* U, const float* __restrict__ cw, int kwid) {
    const int tidx = tid_op(kwid), lane = tidx & 63, gw = blockIdx.x * 8 + (tidx >> 6), nw = gridDim.x * 8;
    for (int u = gw; u < 2560; u += nw) {
        const int cgp = u % 10, rb = u / 10, c0 = cgp * 512 + lane * 8, r0 = rb * 64;
        float w0[8], w1[8], w2[8], p2[8], p1[8];
#pragma unroll
        for (int k = 0; k < 8; ++k) { w0[k] = cw[c0 + k]; w1[k] = cw[5120 + c0 + k]; w2[k] = cw[10240 + c0 + k]; p2[k] = 0.f; p1[k] = 0.f; }
        if (r0 > 0) { unpack8(*(const u32x4*)(Gm + (size_t)(r0 - 2) * 5120 + c0), p2); unpack8(*(const u32x4*)(Gm + (size_t)(r0 - 1) * 5120 + c0), p1); }
        for (int r = r0; r < r0 + 64; r += 4) {
            u32x4 gq[4], uq[4];
#pragma unroll
            for (int q = 0; q < 4; ++q) { gq[q] = *(const u32x4*)(Gm + (size_t)(r + q) * 5120 + c0); uq[q] = *(const u32x4*)(U + (size_t)(r + q) * 5120 + c0); }
#pragma unroll
            for (int q = 0; q < 4; ++q) {
                float gv[8], uv[8], hv[8];
                unpack8(gq[q], gv); unpack8(uq[q], uv);
#pragma unroll
                for (int k = 0; k < 8; ++k) { const float gate = w0[k] * p2[k] + w1[k] * p1[k] + w2[k] * gv[k]; hv[k] = siluf(gate) * uv[k]; p2[k] = p1[k]; p1[k] = gv[k]; }
                *(u32x4*)(U + (size_t)(r + q) * 5120 + c0) = pack8(hv);
            }
        }
    }
}

__device__ __forceinline__ uint2 pk4(const f32x4 v) { uint2 w; w.x = pack2(v[0], v[1]); w.y = pack2(v[2], v[3]); return w; }
struct Seg { bf16_t* ptr; int pn1; int pn_stride; int chunk_stride; int row_stride; int bj_stride; };
struct F32Tgt { float* ptr; int lc0, lc1, ld; float scale; };
struct EpiRoute {
    static constexpr bool PERM = false, AFTER_DRAIN = false;
    Seg seg[4]; int nseg; bf16_t* halo; int halo_pn; int fpn; F32Tgt ft0, ft1;
    static __device__ __forceinline__ void f32store(const F32Tgt& t, const f32x4 (&acc)[2][2][4][2], int row0, int lc0) {
        if (!t.ptr) return;
#pragma unroll
        for (int bj = 0; bj < 2; ++bj)
#pragma unroll
            for (int n = 0; n < 2; ++n) {
                const int lc = lc0 + bj * 128 + n * 16;
                if (lc >= t.lc0 && lc < t.lc1) {
#pragma unroll
                    for (int ai = 0; ai < 2; ++ai)
#pragma unroll
                        for (int m = 0; m < 4; ++m) *(f32x4*)(t.ptr + (size_t)(row0 + ai * 128 + m * 16) * t.ld + (lc - t.lc0)) = acc[ai][bj][m][n] * t.scale;
                }
            }
    }
    __device__ __forceinline__ void operator()(const f32x4 (&acc)[2][2][4][2], const pg8::Unit& u, int wr, int wc, int fr, int fq) const {
        const int row0 = u.pm * 256 + wr * 64 + fr, lc0 = wc * 32 + 4 * fq, pn = u.pn;
        if (pn == fpn) { f32store(ft0, acc, row0, lc0); f32store(ft1, acc, row0, lc0); return; }
        Seg sg = seg[0]; int pnb = 0;
        if (nseg > 1 && pn >= seg[0].pn1) { sg = seg[1]; pnb = seg[0].pn1; }
        if (nseg > 2 && pn >= seg[1].pn1) { sg = seg[2]; pnb = seg[1].pn1; }
        if (nseg > 3 && pn >= seg[2].pn1) { sg = seg[3]; pnb = seg[2].pn1; }
        if (pn >= sg.pn1) return;
        bf16_t* base = sg.ptr + (size_t)(pn - pnb) * sg.pn_stride + lc0;
        const int cs = sg.chunk_stride, rs = sg.row_stride, bs = sg.bj_stride;
#pragma unroll
        for (int ai = 0; ai < 2; ++ai)
#pragma unroll
            for (int m = 0; m < 4; ++m) {
                const int row = row0 + ai * 128 + m * 16;
                bf16_t* rp = base + (size_t)(row >> 6) * cs + (row & 63) * rs;
#pragma unroll
                for (int bj = 0; bj < 2; ++bj)
#pragma unroll
                    for (int n = 0; n < 2; ++n) *(uint2*)(rp + bj * bs + n * 16) = pk4(acc[ai][bj][m][n]);
            }
        if (halo && pn < halo_pn && fr >= 13) {
#pragma unroll
            for (int ai = 0; ai < 2; ++ai) {
                const int row = row0 + ai * 128 + 48;
                bf16_t* hp = halo + ((size_t)(row >> 6) * 3 + (fr - 13)) * 8192 + pn * 256 + lc0;
#pragma unroll
                for (int bj = 0; bj < 2; ++bj)
#pragma unroll
                    for (int n = 0; n < 2; ++n) *(uint2*)(hp + bj * 128 + n * 16) = pk4(acc[ai][bj][3][n]);
            }
        }
    }
};
struct EpiResid {
    static constexpr bool PERM = false, AFTER_DRAIN = false;
    const float* rf; const bf16_t* rb; bf16_t* Y;
    __device__ __forceinline__ void operator()(const f32x4 (&acc)[2][2][4][2], const pg8::Unit& u, int wr, int wc, int fr, int fq) const {
        const int row0 = u.pm * 256 + wr * 64 + fr, col0 = u.pn * 256 + wc * 32 + 4 * fq;
#pragma unroll
        for (int ai = 0; ai < 2; ++ai)
#pragma unroll
            for (int m = 0; m < 4; ++m) {
                const size_t o = (size_t)(row0 + ai * 128 + m * 16) * DM + col0;
#pragma unroll
                for (int bj = 0; bj < 2; ++bj)
#pragma unroll
                    for (int n = 0; n < 2; ++n) {
                        f32x4 r;
                        if (rf) r = *(const f32x4*)(rf + o + bj * 128 + n * 16);
                        else { const uint2 w = *(const uint2*)(rb + o + bj * 128 + n * 16); r[0] = bflo(w.x); r[1] = bfhi(w.x); r[2] = bflo(w.y); r[3] = bfhi(w.y); }
                        *(uint2*)(Y + o + bj * 128 + n * 16) = pk4(r * DN_ALPHA + acc[ai][bj][m][n]);
                    }
            }
    }
};
struct EpiPle {
    static constexpr bool PERM = false, AFTER_DRAIN = false;
    const float* x2; const bf16_t* PP; bf16_t* xb; float* fo;
    __device__ __forceinline__ void operator()(const f32x4 (&acc)[2][2][4][2], const pg8::Unit& u, int wr, int wc, int fr, int fq) const {
        const int row0 = u.pm * 256 + wr * 64 + fr, col0 = u.pn * 256 + wc * 32 + 4 * fq;
#pragma unroll
        for (int ai = 0; ai < 2; ++ai)
#pragma unroll
            for (int m = 0; m < 4; ++m) {
                const size_t o = (size_t)(row0 + ai * 128 + m * 16) * DM + col0;
#pragma unroll
                for (int bj = 0; bj < 2; ++bj)
#pragma unroll
                    for (int n = 0; n < 2; ++n) {
                        const size_t oo = o + bj * 128 + n * 16; const f32x4 v = acc[ai][bj][m][n];
                        const f32x4 x = *(const f32x4*)(x2 + oo); const uint2 w = *(const uint2*)(PP + oo);
                        f32x4 r; r[0] = x[0] + sigmoidf_(v[0]) * bflo(w.x); r[1] = x[1] + sigmoidf_(v[1]) * bfhi(w.x); r[2] = x[2] + sigmoidf_(v[2]) * bflo(w.y); r[3] = x[3] + sigmoidf_(v[3]) * bfhi(w.y);
                        if (xb) *(uint2*)(xb + oo) = pk4(r); else *(f32x4*)(fo + oo) = r;
                    }
            }
    }
};
template <class E> __device__ __forceinline__ void run_gemm(LAS unsigned char* lds, int kwid, const bf16_t* A, const bf16_t* Bt, int N, int K, const E& e) {
    pg8::Gemm g; g.A = A; g.Bt = Bt; g.M = T; g.N = N; g.K = K;
    pg8::StaticOrder S; S.init(T, N, (int)gridDim.x, (int)blockIdx.x);
    pg8::gemm_phase<E, pg8::StaticOrder, false>(lds, g, S, e, nullptr, kwid);
}
__device__ __forceinline__ Seg mkseg(bf16_t* p, int pn1, int pns, int cs, int rs, int bs) { Seg s; s.ptr = p; s.pn1 = pn1; s.pn_stride = pns; s.chunk_stride = cs; s.row_stride = rs; s.bj_stride = bs; return s; }
__device__ __forceinline__ EpiRoute mkroute() { EpiRoute e; e.nseg = 0; e.halo = nullptr; e.halo_pn = 0; e.fpn = -1; e.ft0.ptr = nullptr; e.ft1.ptr = nullptr;
    for (int i = 0; i < 4; ++i) e.seg[i] = mkseg(nullptr, 0, 0, 0, 0, 0);
    e.ft0.lc0 = 0; e.ft0.lc1 = 0; e.ft0.ld = 0; e.ft0.scale = 1.f; e.ft1 = e.ft0; return e; }
__device__ __forceinline__ bf16_t* gdn_wptr(unsigned char* ws, int h) { return (bf16_t*)(ws + (h < 12 ? (size_t)h * 4 * MiB : (size_t)(497 + (h - 12) * 4) * MiB)); }

__device__ __forceinline__ void gdn_g1(const KP& p, unsigned char* ws, LAS unsigned char* ldsb, int kwid, const bool dry = false) {
    LAS float* qs = (LAS float*)ldsb; LAS float* ks = qs + 64 * 129;
    LAS bf16_t* Am = (LAS bf16_t*)qs; LAS float* KKs = ks; LAS float* QKs = KKs + 64 * 64;
    LAS bf16_t* qb = (LAS bf16_t*)(ldsb + 66048); LAS bf16_t* kb = qb + 64 * 136;
    LAS float* gcs = (LAS float*)(ldsb + 66048 + 34816); LAS float* bts = gcs + 128;
    bf16_t* Qb = (bf16_t*)(ws + 113 * MiB); bf16_t* Kb = (bf16_t*)(ws + 177 * MiB); bf16_t* Vb = (bf16_t*)(ws + 241 * MiB);
    float* AB = (float*)(ws + 577 * MiB); const bf16_t* HALO = (const bf16_t*)(ws + 581 * MiB); bf16_t* qkd = (bf16_t*)(ws + 49 * MiB); float* gcb = (float*)(ws + 601 * MiB);
    const float* convw = p.in[3]; const float* a_log = p.in[4]; const float* dt_bias = p.in[5];
    for (int unit = blockIdx.x; unit < 4096; unit += gridDim.x) {
        const int tid = tid_op(kwid), lane = tid & 63, wv = kwid;
        const int j = unit & 15, n = unit >> 4;
        {
            const int c = tid & 127, rg = tid >> 7;
#pragma unroll
            for (int which = 0; which < 2; ++which) {
                const bf16_t* src = (which ? Kb : Qb) + (size_t)(n * 16 + j) * 8192 + c;
                const int ch = which * 2048 + j * 128 + c;
                const float w0 = convw[ch], w1 = convw[8192 + ch], w2 = convw[2 * 8192 + ch], w3 = convw[3 * 8192 + ch];
                float xm3 = 0.f, xm2 = 0.f, xm1 = 0.f;
                if (rg > 0) { xm3 = bf2f(src[(rg * 16 - 3) * 128]); xm2 = bf2f(src[(rg * 16 - 2) * 128]); xm1 = bf2f(src[(rg * 16 - 1) * 128]); }
                else if (n > 0) { const bf16_t* hp = HALO + (size_t)(n - 1) * 3 * 8192 + ch; xm3 = bf2f(hp[0]); xm2 = bf2f(hp[8192]); xm1 = bf2f(hp[2 * 8192]); }
                LAS float* dst = which ? ks : qs;
#pragma unroll
                for (int i = 0; i < 16; ++i) {
                    const float x0 = bf2f(src[(rg * 16 + i) * 128]);
                    const float y = w0 * xm3 + w1 * xm2 + w2 * xm1 + w3 * x0;
                    dst[(rg * 16 + i) * 129 + c] = siluf(y);
                    xm3 = xm2; xm2 = xm1; xm1 = x0;
                }
            }
        }
        __syncthreads();
        int lane_u = lane; asm volatile("" : "+v"(lane_u));
#pragma unroll
        for (int rr = 0; rr < 8; ++rr) {
            const int i = wv * 8 + rr;
            float a0 = qs[i * 129 + lane], a1 = qs[i * 129 + 64 + lane];
            float ss = wsum_l(a0 * a0 + a1 * a1, lane_u); float sc = rsqrtf(ss + 1e-6f) * 0.08838834764831845f;
            qb[i * 136 + lane] = f2bf(a0 * sc); qb[i * 136 + 64 + lane] = f2bf(a1 * sc);
            a0 = ks[i * 129 + lane]; a1 = ks[i * 129 + 64 + lane];
            ss = wsum_l(a0 * a0 + a1 * a1, lane_u); sc = rsqrtf(ss + 1e-6f);
            kb[i * 136 + lane] = f2bf(a0 * sc); kb[i * 136 + 64 + lane] = f2bf(a1 * sc);
        }
        __syncthreads();
        {
            const int l15 = lane & 15, lq = lane >> 4, tr = wv >> 1, tc0 = 2 * (wv & 1);
            bf16x8 aK[4], aQ[4];
#pragma unroll
            for (int ksx = 0; ksx < 4; ++ksx) { aK[ksx] = *(LAS const bf16x8*)(kb + (16 * tr + l15) * 136 + 32 * ksx + 8 * lq); aQ[ksx] = *(LAS const bf16x8*)(qb + (16 * tr + l15) * 136 + 32 * ksx + 8 * lq); }
#pragma unroll
            for (int tcx = 0; tcx < 2; ++tcx) {
                const int tc = tc0 + tcx;
                f32x4 cK = {0.f, 0.f, 0.f, 0.f}, cQ = {0.f, 0.f, 0.f, 0.f};
#pragma unroll
                for (int ksx = 0; ksx < 4; ++ksx) {
                    const bf16x8 b = *(LAS const bf16x8*)(kb + (16 * tc + l15) * 136 + 32 * ksx + 8 * lq);
                    cK = __builtin_amdgcn_mfma_f32_16x16x32_bf16(aK[ksx], b, cK, 0, 0, 0);
                    cQ = __builtin_amdgcn_mfma_f32_16x16x32_bf16(aQ[ksx], b, cQ, 0, 0, 0);
                }
#pragma unroll
                for (int r = 0; r < 4; ++r) { KKs[(16 * tr + 4 * lq + r) * 64 + 16 * tc + l15] = cK[r]; QKs[(16 * tr + 4 * lq + r) * 64 + 16 * tc + l15] = cQ[r]; }
            }
            {
                const int i = tid >> 3, d0 = (tid & 7) * 16;
                bf16_t* dst = Qb + (size_t)(n * 16 + j) * 8192 + i * 128 + d0;
                const u32x4 v0 = *(LAS const u32x4*)(qb + i * 136 + d0), v1 = *(LAS const u32x4*)(qb + i * 136 + d0 + 8);
                if (!dry) { *(u32x4*)dst = v0; *(u32x4*)(dst + 8) = v1; }
            }
            {
                const int d = tid >> 2, i0 = (tid & 3) * 16; unsigned pk[8];
#pragma unroll
                for (int e = 0; e < 8; ++e) pk[e] = (unsigned)kb[(i0 + 2 * e) * 136 + d] | ((unsigned)kb[(i0 + 2 * e + 1) * 136 + d] << 16);
                bf16_t* dst = Kb + (size_t)(n * 16 + j) * 8192 + d * 64 + i0;
                u32x4 v0, v1; v0.x = pk[0]; v0.y = pk[1]; v0.z = pk[2]; v0.w = pk[3]; v1.x = pk[4]; v1.y = pk[5]; v1.z = pk[6]; v1.w = pk[7];
                if (!dry) { *(u32x4*)dst = v0; *(u32x4*)(dst + 8) = v1; }
            }
        }
        int tl_ = tid & 255; asm volatile("" : "+v"(tl_));
        const int hh = tid >> 8, tl = tl_, h = 2 * j + hh;
        if (tl < 64) {
            const int row = n * 64 + tl;
            const float a = AB[(size_t)row * 64 + h], b = AB[(size_t)row * 64 + 32 + h];
            const float x = a + dt_bias[h];
            const float sp = (x > 20.f) ? x : log1pf(expf(x));
            float gc = -expf(a_log[h]) * sp;
#pragma unroll
            for (int off = 1; off < 64; off <<= 1) { const float t = bperm_f((lane_u - off) & 63, gc); if (lane_u >= off) gc += t; }
            gcs[hh * 64 + tl] = gc; bts[hh * 64 + tl] = 1.0f / (1.0f + expf(-b));
            if (!dry) gcb[(size_t)h * T + row] = gc;
        }
        __syncthreads();
        {
            const int i = tl >> 2, jx0 = (tl & 3) * 16;
            const float gi = gcs[hh * 64 + i], bi = bts[hh * 64 + i]; float f[16], am[16];
#pragma unroll
            for (int k = 0; k < 16; ++k) {
                const int jx = jx0 + k;
                const float dec = (jx <= i) ? __expf(gi - gcs[hh * 64 + jx]) : 0.f;
                am[k] = (jx < i) ? bi * KKs[i * 64 + jx] * dec : 0.f;
                f[k] = QKs[i * 64 + jx] * dec;
            }
            *(LAS u32x4*)(Am + hh * 4096 + i * 64 + jx0) = pack8(am); *(LAS u32x4*)(Am + hh * 4096 + i * 64 + jx0 + 8) = pack8(am + 8);
            bf16_t* dst = qkd + ((size_t)(h * 256 + n) * 64 + i) * 64 + jx0;
            if (!dry) { *(u32x4*)dst = pack8(f); *(u32x4*)(dst + 8) = pack8(f + 8); }
        }
        __syncthreads();
        {
            const int c = tl; float X[64];
            LAS const float* bt = bts + hh * 64; LAS const float* gcp = gcs + hh * 64;
            if (c < 128) {
                const bf16_t* src = Vb + (size_t)(n * 32 + h) * 8192 + c;
                const int ch = 4096 + h * 128 + c;
                const float w0 = convw[ch], w1 = convw[8192 + ch], w2 = convw[2 * 8192 + ch], w3 = convw[3 * 8192 + ch];
                float xm3 = 0.f, xm2 = 0.f, xm1 = 0.f;
                if (n > 0) { const bf16_t* hp = HALO + (size_t)(n - 1) * 3 * 8192 + ch; xm3 = bf2f(hp[0]); xm2 = bf2f(hp[8192]); xm1 = bf2f(hp[2 * 8192]); }
#pragma unroll
                for (int i = 0; i < 64; ++i) {
                    const float x0 = bf2f(src[i * 128]);
                    const float y = w0 * xm3 + w1 * xm2 + w2 * xm1 + w3 * x0;
                    X[i] = bt[i] * siluf(y);
                    xm3 = xm2; xm2 = xm1; xm1 = x0;
                }
            } else {
                const int d = c - 128;
#pragma unroll
                for (int i = 0; i < 64; ++i) X[i] = bt[i] * __expf(gcp[i]) * bf2f(kb[i * 136 + d]);
            }
            LAS const bf16_t* Ah = Am + hh * 4096;
#pragma clang loop unroll(full)
            for (int i = 1; i < 64; ++i) {
                float s0 = 0.f, s1 = 0.f, s2 = 0.f, s3 = 0.f;
#pragma clang loop unroll(full)
                for (int j8 = 0; j8 < 8; ++j8) if (j8 * 8 < i) {
                    const u32x4 a8 = *(LAS const u32x4*)(Ah + i * 64 + j8 * 8);
                    if (j8 * 8 + 0 < i) s0 += bflo(a8.x) * X[j8 * 8 + 0];
                    if (j8 * 8 + 1 < i) s1 += bfhi(a8.x) * X[j8 * 8 + 1];
                    if (j8 * 8 + 2 < i) s2 += bflo(a8.y) * X[j8 * 8 + 2];
                    if (j8 * 8 + 3 < i) s3 += bfhi(a8.y) * X[j8 * 8 + 3];
                    if (j8 * 8 + 4 < i) s0 += bflo(a8.z) * X[j8 * 8 + 4];
                    if (j8 * 8 + 5 < i) s1 += bfhi(a8.z) * X[j8 * 8 + 5];
                    if (j8 * 8 + 6 < i) s2 += bflo(a8.w) * X[j8 * 8 + 6];
                    if (j8 * 8 + 7 < i) s3 += bfhi(a8.w) * X[j8 * 8 + 7];
                }
                X[i] -= (s0 + s1) + (s2 + s3);
            }
            if (c < 128) {
                bf16_t* dst = Vb + (size_t)(n * 32 + h) * 8192 + c;
#pragma unroll
                for (int i = 0; i < 64; ++i) if (!dry) dst[i * 128] = f2bf(X[i]);
            } else {
                bf16_t* dst = gdn_wptr(ws, h) + (size_t)(n * 64) * 128 + (c - 128);
#pragma unroll
                for (int i = 0; i < 64; ++i) if (!dry) dst[i * 128] = f2bf(X[i]);
            }
        }
        __syncthreads();
    }
}

__device__ __forceinline__ void gdn_g2(unsigned char* ws, LAS unsigned char* lds, int kwid, const bool dry = false) {
    constexpr int BUFSZ = 62464, OFF_W = 0, OFF_Q = 17408, OFF_K = 34816, OFF_QK = 53248, OFF_ST = 2 * BUFSZ, OFF_VN = OFF_ST + 4352, OFF_VS = OFF_VN + 2304;
    const bf16_t* Qb = (const bf16_t*)(ws + 113 * MiB); const bf16_t* Kb = (const bf16_t*)(ws + 177 * MiB); bf16_t* Vb = (bf16_t*)(ws + 241 * MiB);
    const bf16_t* qkd = (const bf16_t*)(ws + 49 * MiB); const float* gcb = (const float*)(ws + 601 * MiB);
    const int tid = tid_op(kwid), lane = tid & 63, w = tid >> 6, l15 = lane & 15, lq = lane >> 4, mt = w & 3;
    for (int u0 = blockIdx.x; u0 < 256; u0 += gridDim.x) {
        const int unit = (gridDim.x == 256) ? ((u0 & 7) * 32 + (u0 >> 3)) : u0;
        const int h = unit >> 3, s = unit & 7, j = h >> 1;
        const bf16_t* wh = gdn_wptr(ws, h);
        const float* gch = gcb + (size_t)h * T;
        f32x4 Sacc = {0.f, 0.f, 0.f, 0.f};
        for (int i = tid; i < (4352 + 2304 + 2304) / 4; i += 512) ((LAS unsigned*)(lds + OFF_ST))[i] = 0u;
        u32x4 RA[7], RB[7]; unsigned short unA[4], unB[4]; f32x4 gcnA, gcnB; float glnA, glnB;
#define G2_LOAD(X, nn) do { \
            _Pragma("unroll") for (int k = 0; k < 7; ++k) { const int pid = tid + 512 * k; const bf16_t* src; \
                if (k < 2) src = wh + (size_t)(nn) * 8192 + (size_t)pid * 8; \
                else if (k < 4) src = Qb + (size_t)((nn) * 16 + j) * 8192 + (size_t)(pid - 1024) * 8; \
                else if (k < 6) src = Kb + (size_t)((nn) * 16 + j) * 8192 + (size_t)(pid - 2048) * 8; \
                else src = qkd + (size_t)(h * 256 + (nn)) * 4096 + (size_t)(pid - 3072) * 8; \
                R##X[k] = *(const u32x4*)src; } \
            { const bf16_t* up = Vb + (size_t)((nn) * 32 + h) * 8192 + (size_t)(16 * mt + 4 * lq) * 128 + s * 16 + l15; \
              un##X[0] = up[0]; un##X[1] = up[128]; un##X[2] = up[256]; un##X[3] = up[384]; } \
            gcn##X = *(const f32x4*)(gch + (nn) * 64 + 16 * mt + 4 * lq); gln##X = gch[(nn) * 64 + 63]; } while (0)
#define G2_STORE(X, bufoff) do { \
            _Pragma("unroll") for (int k = 0; k < 7; ++k) { const int pid = tid + 512 * k; int off; \
                if (k < 2) off = OFF_W + ((pid >> 4) * 136 + (pid & 15) * 8) * 2; \
                else if (k < 4) off = OFF_Q + (((pid - 1024) >> 4) * 136 + ((pid - 1024) & 15) * 8) * 2; \
                else if (k < 6) off = OFF_K + (((pid - 2048) >> 3) * 72 + ((pid - 2048) & 7) * 8) * 2; \
                else off = OFF_QK + (((pid - 3072) >> 3) * 72 + ((pid - 3072) & 7) * 8) * 2; \
                *(LAS u32x4*)(lds + (bufoff) + off) = R##X[k]; } \
            _Pragma("unroll") for (int r = 0; r < 4; ++r) uc[r] = bf2f(un##X[r]); \
            gcc = gcn##X; glc = gln##X; } while (0)
        float uc[4]; f32x4 gcc; float glc;
        G2_LOAD(A, 0);
        G2_STORE(A, 0);
        G2_LOAD(B, 1);
        __syncthreads();
#define G2_STEP(n, XL, XS) do { \
            const int bo = ((n) & 1) * BUFSZ; \
            G2_LOAD(XL, ((n) + 2 < 256 ? (n) + 2 : 255));     \
            f32x4 acc = {0.f, 0.f, 0.f, 0.f}; \
            { LAS const unsigned char* Ab = lds + bo + (w < 4 ? OFF_W : OFF_Q) + ((16 * mt + l15) * 136 + 8 * lq) * 2; \
              LAS const unsigned char* Bb = lds + OFF_ST + (l15 * 136 + 8 * lq) * 2; \
              _Pragma("unroll") for (int ksx = 0; ksx < 4; ++ksx) { \
                  const bf16x8 a = *(LAS const bf16x8*)(Ab + ksx * 64), b = *(LAS const bf16x8*)(Bb + ksx * 64); \
                  acc = __builtin_amdgcn_mfma_f32_16x16x32_bf16(a, b, acc, 0, 0, 0); } } \
            if (w < 4) { \
                float vn[4], vs[4]; \
                _Pragma("unroll") for (int r = 0; r < 4; ++r) { vn[r] = uc[r] - acc[r]; vs[r] = vn[r] * __expf(glc - gcc[r]); } \
                u32x2 a; a[0] = pack2(vn[0], vn[1]); a[1] = pack2(vn[2], vn[3]); \
                u32x2 b; b[0] = pack2(vs[0], vs[1]); b[1] = pack2(vs[2], vs[3]); \
                *(LAS u32x2*)(lds + OFF_VN + (l15 * 72 + 16 * mt + 4 * lq) * 2) = a; \
                *(LAS u32x2*)(lds + OFF_VS + (l15 * 72 + 16 * mt + 4 * lq) * 2) = b; } \
            __syncthreads(); \
            if (w >= 4) { \
                f32x4 o; \
                _Pragma("unroll") for (int r = 0; r < 4; ++r) o[r] = __expf(gcc[r]) * acc[r]; \
                LAS const unsigned char* Ab = lds + bo + OFF_QK + ((16 * mt + l15) * 72 + 8 * lq) * 2; \
                LAS const unsigned char* Bb = lds + OFF_VN + (l15 * 72 + 8 * lq) * 2; \
                _Pragma("unroll") for (int ksx = 0; ksx < 2; ++ksx) { \
                    const bf16x8 a = *(LAS const bf16x8*)(Ab + ksx * 64), b = *(LAS const bf16x8*)(Bb + ksx * 64); \
                    o = __builtin_amdgcn_mfma_f32_16x16x32_bf16(a, b, o, 0, 0, 0); } \
                bf16_t* op = Vb + (size_t)((n) * 32 + h) * 8192 + (size_t)(16 * mt + 4 * lq) * 128 + s * 16 + l15; \
                if (!dry) { op[0] = f2bf(o[0]); op[128] = f2bf(o[1]); op[256] = f2bf(o[2]); op[384] = f2bf(o[3]); } } \
            { const float gf = __expf(glc); \
              _Pragma("unroll") for (int r = 0; r < 4; ++r) Sacc[r] *= gf; \
              LAS const unsigned char* Ab = lds + bo + OFF_K + ((16 * w + l15) * 72 + 8 * lq) * 2; \
              LAS const unsigned char* Bb = lds + OFF_VS + (l15 * 72 + 8 * lq) * 2; \
              _Pragma("unroll") for (int ksx = 0; ksx < 2; ++ksx) { \
                  const bf16x8 a = *(LAS const bf16x8*)(Ab + ksx * 64), b = *(LAS const bf16x8*)(Bb + ksx * 64); \
                  Sacc = __builtin_amdgcn_mfma_f32_16x16x32_bf16(a, b, Sacc, 0, 0, 0); } \
              u32x2 sv; sv[0] = pack2(Sacc[0], Sacc[1]); sv[1] = pack2(Sacc[2], Sacc[3]); \
              *(LAS u32x2*)(lds + OFF_ST + (l15 * 136 + 16 * w + 4 * lq) * 2) = sv; } \
            if ((n) + 1 < 256) G2_STORE(XS, (((n) + 1) & 1) * BUFSZ); \
            __syncthreads(); } while (0)
        for (int n = 0; n < 256; n += 2) { G2_STEP(n, A, B); G2_STEP(n + 1, B, A); }
#undef G2_STEP
#undef G2_LOAD
#undef G2_STORE
    }
}

__device__ __forceinline__ void gdn_g3(const float* __restrict__ norm_g, const bf16_t* Ob, bf16_t* Z, int kwid) {
    const int tidx = tid_op(kwid), lane = tidx & 63, sub = lane & 15, gw = blockIdx.x * 8 + (tidx >> 6), nw = gridDim.x * 8;
    float ng[8];
#pragma unroll
    for (int k = 0; k < 8; ++k) ng[k] = norm_g[sub * 8 + k];
    for (int pi = gw * 4 + (lane >> 4); pi < T * 32; pi += nw * 8) {
        u32x4 oq[2], zq[2]; bf16_t* zp[2];
#pragma unroll
        for (int q = 0; q < 2; ++q) {
            const int pj = pi + q * nw * 4, t = pj >> 5, h = pj & 31;
            oq[q] = *(const u32x4*)(Ob + ((size_t)((t >> 6) * 32 + h) * 64 + (t & 63)) * 128 + sub * 8);
            zp[q] = Z + (size_t)t * 4096 + h * 128 + sub * 8;
            zq[q] = *(const u32x4*)zp[q];
        }
#pragma unroll
        for (int q = 0; q < 2; ++q) {
            float o[8], z[8], r[8];
            unpack8(oq[q], o); unpack8(zq[q], z);
            float ss = 0.f;
#pragma unroll
            for (int k = 0; k < 8; ++k) ss += o[k] * o[k];
            ss += __shfl_xor(ss, 1); ss += __shfl_xor(ss, 2); ss += __shfl_xor(ss, 4); ss += __shfl_xor(ss, 8);
            const float rs = rsqrtf(ss * (1.0f / 128.0f) + 1e-6f);
#pragma unroll
            for (int k = 0; k < 8; ++k) r[k] = o[k] * rs * ng[k] * siluf(z[k]);
            *(u32x4*)zp[q] = pack8(r);
        }
    }
}
__device__ __forceinline__ void dsa_kiln(const float* ki, const float* __restrict__ g, const float* __restrict__ b, bf16_t* out, int kwid) {
    const int tidx = tid_op(kwid), lane = tidx & 63, gw = blockIdx.x * 8 + (tidx >> 6), nw = gridDim.x * 8;
    const float g0 = g[lane * 2], g1 = g[lane * 2 + 1], b0 = b[lane * 2], b1 = b[lane * 2 + 1];
    for (int row = gw; row < T; row += nw) {
        const float2 v = *(const float2*)(ki + (size_t)row * 128 + lane * 2);
        const float mean = wave_sum(v.x + v.y) * (1.0f / 128.0f);
        const float d0 = v.x - mean, d1 = v.y - mean;
        const float var = wave_sum(d0 * d0 + d1 * d1) * (1.0f / 128.0f);
        const float rstd = rsqrtf(var + 1e-5f);
        *(unsigned*)(out + (size_t)row * 128 + lane * 2) = pack2(d0 * rstd * g0 + b0, d1 * rstd * g1 + b1);
    }
}
__device__ __forceinline__ float relu_i(float x) { const int b = __float_as_int(x); return __int_as_float(b > 0 ? b : 0); }
__device__ __forceinline__ unsigned ord_key(float f) { const unsigned u = __float_as_uint(f); return (u & 0x80000000u) ? ~u : (u | 0x80000000u); }
__device__ __forceinline__ int rel_bucket(int d) {
    if (d < 16) return d;
    const float v = logf((float)d * 0.0625f) * 7.694248476257048f;
    const int l = 16 + (int)v; return l < 31 ? l : 31;
}
template <bool PACKED> __device__ __forceinline__ int radix_pick_t(LAS unsigned* hist, int nb, int lane, int& kth, int& cbin) {
    const int per = nb >> 6, base = lane * per;
    int tot = 0;
    for (int b = 0; b < per; ++b) { const int bb = base + b; tot += PACKED ? (int)((hist[bb >> 1] >> (16 * (bb & 1))) & 0xffffu) : (int)hist[bb]; }
    int v = tot;
#pragma unroll
    for (int off = 1; off < 64; off <<= 1) { const int t = bperm_i((lane + off) & 63, v); if (lane + off < 64) v += t; }
    const int excl = v - tot;
    const bool mine = (excl < kth) && (v >= kth);
    int dsel = 0, ksel = 0, csel = 0, c = excl; bool found = false;
    for (int b = per - 1; b >= 0; --b) { const int bb = base + b; const int hv = PACKED ? (int)((hist[bb >> 1] >> (16 * (bb & 1))) & 0xffffu) : (int)hist[bb];
        if (mine && !found && c + hv >= kth) { dsel = bb; ksel = kth - c; csel = hv; found = true; } c += hv; }
    const unsigned long long m = __ballot(mine);
    const int src = __builtin_amdgcn_readfirstlane((m == 0ull) ? 0 : (__ffsll((long long)m) - 1));
    dsel = __builtin_amdgcn_readlane(dsel, src); ksel = __builtin_amdgcn_readlane(ksel, src); cbin = __builtin_amdgcn_readlane(csel, src);
    kth = ksel; return dsel;
}
__device__ __forceinline__ int radix_pick(LAS unsigned* hist, int nb, int lane, int& kth) { int c; return radix_pick_t<false>(hist, nb, lane, kth, c); }

__device__ __forceinline__ void dsa_phase(const bf16_t* qi, const bf16_t* kib, const float* wi, bf16_t* q1, const bf16_t* k1, const bf16_t* v1,
                                          float* scratch, const float* __restrict__ rel_bias, LAS unsigned char* lds, int kwid) {
    LAS bf16_t* kit = (LAS bf16_t*)(lds + 65536);
    LAS int* sel = (LAS int*)(lds + 135168);
    float* sc = scratch + (size_t)blockIdx.x * 16 * T;
    for (int kk = blockIdx.x; kk < 512; kk += gridDim.x)
#pragma unroll 1
        for (int half = 0; half < 2; ++half) {
            const int tid = tid_op(kwid), lane = tid & 63, w = __builtin_amdgcn_readfirstlane(tid >> 6), lh = lane >> 5, l31 = lane & 31;
            LAS unsigned* hist = (LAS unsigned*)lds + w * 2048;
            LAS float* qf = (LAS float*)lds + w * 2048;
            LAS bf16_t* pl = (LAS bf16_t*)(lds + 65536) + w * 4096;
            const int unit = half ? 1023 - kk : kk, t0 = unit * 16;
            if (t0 >= 256) {
                const int qg = w & 3, kh = w >> 2;
                bf16x8 af[2][8]; float wv[2][16];
#pragma unroll
                for (int mi = 0; mi < 2; ++mi) {
                    const int tq = t0 + 4 * qg + 2 * mi + (l31 >> 4), hd = l31 & 15;
                    const bf16_t* ap = qi + (size_t)tq * 2048 + hd * 128 + 8 * lh;
#pragma unroll
                    for (int ksx = 0; ksx < 8; ++ksx) af[mi][ksx] = *(const bf16x8*)(ap + ksx * 16);
#pragma unroll
                    for (int r = 0; r < 16; ++r) wv[mi][r] = wi[(size_t)(t0 + 4 * qg + 2 * mi + (r >> 3)) * 16 + (r & 3) + 8 * ((r >> 2) & 1) + 4 * lh];
                }
                const int ntile = (t0 + 16 + 127) >> 7;
                u32x4 pre[4];
#pragma unroll
                for (int i = 0; i < 4; ++i) pre[i] = *(const u32x4*)(kib + (size_t)(tid + 512 * i) * 8);
                __syncthreads();
                {
                    u32x4 z; z.x = z.y = z.z = z.w = 0u;
#pragma unroll
                    for (int i = 0; i < 8; ++i) *(LAS u32x4*)(lds + (size_t)(tid + 512 * i) * 16) = z;
                }
#pragma unroll
                for (int i = 0; i < 4; ++i) { const int pid = tid + 512 * i, row = pid >> 4, c8 = pid & 15; *(LAS u32x4*)(kit + row * 136 + c8 * 8) = pre[i]; }
                __syncthreads();
                for (int kt = 0; kt < ntile; ++kt) {
                    LAS const bf16_t* kcur = kit + (kt & 1) * (128 * 136);
                    {
                        const int ktn = (kt + 1 < ntile) ? kt + 1 : kt;
#pragma unroll
                        for (int i = 0; i < 4; ++i) pre[i] = *(const u32x4*)(kib + (size_t)ktn * 16384 + (size_t)(tid + 512 * i) * 8);
                    }
#pragma unroll
                    for (int nbx = 0; nbx < 2; ++nbx) {
                        const int nb = 2 * kh + nbx;
                        LAS const bf16_t* bp = kcur + (nb * 32 + l31) * 136 + 8 * lh;
                        const int key = kt * 128 + nb * 32 + l31;
                        f32x16 acc0, acc1;
#pragma unroll
                        for (int r = 0; r < 16; ++r) { acc0[r] = 0.f; acc1[r] = 0.f; }
#pragma unroll
                        for (int ksx = 0; ksx < 8; ++ksx) {
                            const bf16x8 b = *(LAS const bf16x8*)(bp + ksx * 16);
                            acc0 = __builtin_amdgcn_mfma_f32_32x32x16_bf16(af[0][ksx], b, acc0, 0, 0, 0);
                            acc1 = __builtin_amdgcn_mfma_f32_32x32x16_bf16(af[1][ksx], b, acc1, 0, 0, 0);
                        }
#pragma unroll
                        for (int mi = 0; mi < 2; ++mi) {
                            float s0 = 0.f, s1 = 0.f;
#pragma unroll
                            for (int r = 0; r < 8; ++r) { const float x0 = mi ? acc1[r] : acc0[r], x1 = mi ? acc1[8 + r] : acc0[8 + r]; s0 += wv[mi][r] * relu_i(x0); s1 += wv[mi][8 + r] * relu_i(x1); }
                            const u32x2 sw_ = __builtin_amdgcn_permlane32_swap(__float_as_uint(s0), __float_as_uint(s1), false, false);
                            const float tot = __uint_as_float(sw_[0]) + __uint_as_float(sw_[1]);
                            const int ql = 4 * qg + 2 * mi + lh;
                            if (key <= t0 + ql) { sc[(size_t)ql * T + key] = tot;
                                const unsigned bin = ord_key(tot) >> 21;
                                __hip_atomic_fetch_add((LAS unsigned*)(lds + ql * 4096) + (bin >> 1), 1u << (16 * (bin & 1u)), __ATOMIC_RELAXED, __HIP_MEMORY_SCOPE_WORKGROUP); }
                        }
                    }
                    if (kt + 1 < ntile) {
                        LAS bf16_t* knext = kit + ((kt + 1) & 1) * (128 * 136);
#pragma unroll
                        for (int i = 0; i < 4; ++i) { const int pid = tid + 512 * i, row = pid >> 4, c8 = pid & 15; *(LAS u32x4*)(knext + row * 136 + c8 * 8) = pre[i]; }
                    }
                    __syncthreads();
                }
            }
            asm volatile("s_waitcnt vmcnt(0)" ::: "memory");
            __builtin_amdgcn_fence(__ATOMIC_ACQUIRE, "agent");
            __syncthreads();
            int d0q[2] = {0, 0}, kthq[2] = {256, 256}, c0q[2] = {0, 0};
            if (t0 >= 256) {
                const int lane0 = tid_op(kwid) & 63;
#pragma unroll
                for (int qx = 0; qx < 2; ++qx) { int kk_ = 256, cc_ = 0; d0q[qx] = radix_pick_t<true>((LAS unsigned*)(lds + (2 * w + qx) * 4096), 2048, lane0, kk_, cc_); kthq[qx] = kk_; c0q[qx] = cc_; }
                wave_sync();
            }
#pragma unroll 1
            for (int qq = 0; qq < 2; ++qq) {
                int lane_q = tid_op(kwid) & 63;
                const int lane = lane_q;
                const int ql = 2 * w + qq, t = t0 + ql, nk = t + 1;
                LAS int* selq = sel + ql * 256;
                int nsel;
                if (nk <= 256) { for (int s = lane; s < nk; s += 64) selq[s] = s; nsel = nk; }
#ifndef DSA_REP_B
#define DSA_REP_B 1
#endif
                else for (int repb = 0; repb < DSA_REP_B; ++repb) {
                    const float* srow = sc + (size_t)ql * T;
                    int kth = qq ? kthq[1] : kthq[0]; unsigned d0 = (unsigned)(qq ? d0q[1] : d0q[0]), d1, d2;
                    const int c0 = qq ? c0q[1] : c0q[0];
                    if (c0 <= 1024) {
                        LAS unsigned* cu = (LAS unsigned*)(lds + 65536) + w * 2048; LAS unsigned* ck = cu + 1024;
                        const unsigned long long ltmask = (lane == 0) ? 0ull : (~0ull >> (64 - lane));
                        int cnt = 0, ccnt = 0;
                        for (int kb = 0; kb < nk; kb += 512) { float fv[8];
#pragma unroll
                            for (int jx = 0; jx < 8; ++jx) { const int key = kb + 64 * jx + lane; fv[jx] = srow[key < nk ? key : nk - 1]; }
#pragma unroll
                            for (int jx = 0; jx < 8; ++jx) {
                                const int key = kb + 64 * jx + lane; const bool in = key < nk;
                                const unsigned u = in ? ord_key(fv[jx]) : 0u; const unsigned bin = u >> 21;
                                const bool gt = in && (bin > d0), eq = in && (bin == d0);
                                const unsigned long long mg = __ballot(gt), me = __ballot(eq);
                                const int pg = cnt + __popcll(mg & ltmask), pe = ccnt + __popcll(me & ltmask);
                                if (gt && pg < 256) selq[pg] = key;
                                if (eq && pe < 1024) { cu[pe] = u; ck[pe] = (unsigned)key; }
                                cnt += __popcll(mg); ccnt += __popcll(me);
                            }
                        }
                        for (int b = lane; b < 2048; b += 64) hist[b] = 0u;
                        wave_sync();
                        for (int i = lane; i < c0; i += 64) __hip_atomic_fetch_add(&hist[(cu[i] >> 10) & 2047u], 1u, __ATOMIC_RELAXED, __HIP_MEMORY_SCOPE_WORKGROUP);
                        wave_sync();
                        d1 = (unsigned)radix_pick(hist, 2048, lane, kth);
                        wave_sync();
                        for (int b = lane; b < 1024; b += 64) hist[b] = 0u;
                        wave_sync();
                        for (int i = lane; i < c0; i += 64) { const unsigned u = cu[i]; if (((u >> 10) & 2047u) == d1) __hip_atomic_fetch_add(&hist[u & 1023u], 1u, __ATOMIC_RELAXED, __HIP_MEMORY_SCOPE_WORKGROUP); }
                        wave_sync();
                        d2 = (unsigned)radix_pick(hist, 1024, lane, kth);
                        wave_sync();
                        const unsigned tau = (d0 << 21) | (d1 << 10) | d2;
                        int eqleft = kth;
                        for (int ib = 0; ib < c0; ib += 64) {
                            const int i = ib + lane; const bool in = i < c0;
                            const unsigned u = in ? cu[i] : 0u;
                            const bool gt = in && (u > tau), eq = in && (u == tau);
                            const unsigned long long meq = __ballot(eq);
                            const bool take = gt || (eq && (__popcll(meq & ltmask) < eqleft));
                            const unsigned long long mt = __ballot(take);
                            const int pos = cnt + __popcll(mt & ltmask);
                            if (take && pos < 256) selq[pos] = (int)ck[i];
                            cnt += __popcll(mt);
                            const int neq = __popcll(meq); eqleft -= (neq < eqleft ? neq : eqleft);
                        }
                    } else {
                    for (int b = lane; b < 2048; b += 64) hist[b] = 0u;
                    wave_sync();
                    for (int key0 = lane; key0 < nk; key0 += 512) { float fv[8];
#pragma unroll
                        for (int jx = 0; jx < 8; ++jx) { const int key = key0 + 64 * jx; fv[jx] = srow[key < nk ? key : nk - 1]; }
#pragma unroll
                        for (int jx = 0; jx < 8; ++jx) { const int key = key0 + 64 * jx; if (key < nk) { const unsigned u = ord_key(fv[jx]); if ((u >> 21) == d0) __hip_atomic_fetch_add(&hist[(u >> 10) & 2047u], 1u, __ATOMIC_RELAXED, __HIP_MEMORY_SCOPE_WORKGROUP); } } }
                    wave_sync();
                    d1 = (unsigned)radix_pick(hist, 2048, lane, kth);
                    wave_sync();
                    for (int b = lane; b < 1024; b += 64) hist[b] = 0u;
                    wave_sync();
                    const unsigned pre = (d0 << 11) | d1;
                    for (int key0 = lane; key0 < nk; key0 += 512) { float fv[8];
#pragma unroll
                        for (int jx = 0; jx < 8; ++jx) { const int key = key0 + 64 * jx; fv[jx] = srow[key < nk ? key : nk - 1]; }
#pragma unroll
                        for (int jx = 0; jx < 8; ++jx) { const int key = key0 + 64 * jx; if (key < nk) { const unsigned u = ord_key(fv[jx]); if ((u >> 10) == pre) __hip_atomic_fetch_add(&hist[u & 1023u], 1u, __ATOMIC_RELAXED, __HIP_MEMORY_SCOPE_WORKGROUP); } } }
                    wave_sync();
                    d2 = (unsigned)radix_pick(hist, 1024, lane, kth);
                    wave_sync();
                    const unsigned tau = (pre << 10) | d2;
                    int cnt = 0, eqleft = kth;
                    const unsigned long long ltmask = (lane == 0) ? 0ull : (~0ull >> (64 - lane));
                    for (int kb = 0; kb < nk; kb += 512) { float fv[8];
#pragma unroll
                        for (int jx = 0; jx < 8; ++jx) { const int key = kb + 64 * jx + lane; fv[jx] = srow[key < nk ? key : nk - 1]; }
#pragma unroll
                        for (int jx = 0; jx < 8; ++jx) {
                            const int key = kb + 64 * jx + lane; const bool in = key < nk;
                            const unsigned u = in ? ord_key(fv[jx]) : 0u;
                            const bool gt = in && (u > tau), eq = in && (u == tau);
                            const unsigned long long meq = __ballot(eq);
                            const bool take = gt || (eq && (__popcll(meq & ltmask) < eqleft));
                            const unsigned long long mt = __ballot(take);
                            const int pos = cnt + __popcll(mt & ltmask);
                            if (take && pos < 256) selq[pos] = key;
                            cnt += __popcll(mt);
                            const int neq = __popcll(meq); eqleft -= (neq < eqleft ? neq : eqleft);
                        }
                    }
                    }
                    nsel = 256;
                }
                wave_sync();
#ifndef DSA_REP_C
#define DSA_REP_C 1
#endif
                for (int repc = 0; repc < DSA_REP_C; ++repc) {
                LAS float* invs = (LAS float*)(lds + 151552) + w * 16;
                {
                    int lane_g = lane_q; asm volatile("" : "+v"(lane_g)); const int lane = lane_g;
                    const int l15 = lane & 15, lq = lane >> 4;
                    bf16x8 af[4];
#pragma unroll
                    for (int ksx = 0; ksx < 4; ++ksx) af[ksx] = *(const bf16x8*)(q1 + (size_t)t * 2048 + l15 * 128 + 32 * ksx + 8 * lq);
                    float mx[4] = {-INFINITY, -INFINITY, -INFINITY, -INFINITY};
                    const int ntile = (nsel + 15) >> 4;
                    bf16x8 bA[4][4], bB[4][4]; int idxA = 0, idxB = 0;
#define ATT_LOAD(X, tl) do { const int s_ = (tl) * 16 + l15; idx##X = (s_ < nsel) ? selq[s_] : 0; \
                        const bf16_t* kr_ = k1 + (size_t)idx##X * 512 + 8 * lq; \
                        _Pragma("unroll") for (int g_ = 0; g_ < 4; ++g_) _Pragma("unroll") for (int k_ = 0; k_ < 4; ++k_) b##X[g_][k_] = *(const bf16x8*)(kr_ + g_ * 128 + 32 * k_); } while (0)
#define ATT_TILE(X, tl) do { const int s_ = (tl) * 16 + l15; const bool valid_ = s_ < nsel; \
                        f32x4 sel_ = {0.f, 0.f, 0.f, 0.f}; \
                        _Pragma("unroll") for (int g_ = 0; g_ < 4; ++g_) { f32x4 acc_ = {0.f, 0.f, 0.f, 0.f}; \
                            _Pragma("unroll") for (int k_ = 0; k_ < 4; ++k_) acc_ = __builtin_amdgcn_mfma_f32_16x16x32_bf16(af[k_], b##X[g_][k_], acc_, 0, 0, 0); \
                            if (lq == g_) sel_ = acc_; } \
                        const int bk_ = rel_bucket(t - idx##X); const f32x4 rb_ = *(const f32x4*)(rel_bias + bk_ * 16 + 4 * lq); \
                        float l_[4]; \
                        _Pragma("unroll") for (int r_ = 0; r_ < 4; ++r_) { l_[r_] = valid_ ? sel_[r_] * 0.08838834764831845f + rb_[r_] : -INFINITY; mx[r_] = fmaxf(mx[r_], l_[r_]); } \
                        u32x2 pk_; pk_[0] = pack2(l_[0], l_[1]); pk_[1] = pack2(l_[2], l_[3]); \
                        *(LAS u32x2*)(pl + s_ * 16 + 4 * lq) = pk_; } while (0)
                    ATT_LOAD(A, 0);
                    for (int tl = 0; tl < ntile; tl += 2) {
                        ATT_LOAD(B, tl + 1);
                        ATT_TILE(A, tl);
                        ATT_LOAD(A, tl + 2);
                        if (tl + 1 < ntile) ATT_TILE(B, tl + 1);
                    }
#undef ATT_LOAD
#undef ATT_TILE
#pragma unroll
                    for (int r = 0; r < 4; ++r) { float m = mx[r]; m = fmaxf(m, bperm_f(lane ^ 8, m)); m = fmaxf(m, bperm_f(lane ^ 4, m)); m = fmaxf(m, bperm_f(lane ^ 2, m)); m = fmaxf(m, bperm_f(lane ^ 1, m)); mx[r] = m; }
                    float sm[4] = {0.f, 0.f, 0.f, 0.f};
#pragma unroll 1
                    for (int tl = 0; tl < ntile; ++tl) {
                        const int s = tl * 16 + l15;
                        const u32x2 pk = *(LAS const u32x2*)(pl + s * 16 + 4 * lq);
                        const float e0 = __expf(bflo(pk[0]) - mx[0]), e1 = __expf(bfhi(pk[0]) - mx[1]), e2 = __expf(bflo(pk[1]) - mx[2]), e3 = __expf(bfhi(pk[1]) - mx[3]);
                        sm[0] += e0; sm[1] += e1; sm[2] += e2; sm[3] += e3;
                        u32x2 po; po[0] = pack2(e0, e1); po[1] = pack2(e2, e3);
                        *(LAS u32x2*)(pl + s * 16 + 4 * lq) = po;
                    }
#pragma unroll
                    for (int r = 0; r < 4; ++r) { float v = sm[r]; v += bperm_f(lane ^ 8, v); v += bperm_f(lane ^ 4, v); v += bperm_f(lane ^ 2, v); v += bperm_f(lane ^ 1, v); if (l15 == 0) invs[4 * lq + r] = 1.0f / v; }
                }
                wave_sync();
                {
                    int lane_p = lane_q; asm volatile("" : "+v"(lane_p)); const int lane = lane_p;
                    const int gl = lane >> 4;
                    float o[4][8];
#pragma unroll
                    for (int hl = 0; hl < 4; ++hl)
#pragma unroll
                        for (int e = 0; e < 8; ++e) o[hl][e] = 0.f;
                    const bf16_t* vb = v1 + lane * 8;
                    int s = 0;
                    for (; s + 8 <= nsel; s += 8) {
                        u32x4 vv[8];
#pragma unroll
                        for (int jx = 0; jx < 8; ++jx) vv[jx] = *(const u32x4*)(vb + (size_t)selq[s + jx] * 512);
#pragma unroll
                        for (int jx = 0; jx < 8; ++jx) {
                            const u32x2 pk = *(LAS const u32x2*)(pl + (s + jx) * 16 + 4 * gl);
                            const float p0 = bflo(pk[0]), p1 = bfhi(pk[0]), p2 = bflo(pk[1]), p3 = bfhi(pk[1]);
                            float vf[8]; unpack8(vv[jx], vf);
#pragma unroll
                            for (int e = 0; e < 8; ++e) { o[0][e] += p0 * vf[e]; o[1][e] += p1 * vf[e]; o[2][e] += p2 * vf[e]; o[3][e] += p3 * vf[e]; }
                        }
                    }
                    for (; s < nsel; ++s) {
                        const u32x4 vv = *(const u32x4*)(vb + (size_t)selq[s] * 512);
                        const u32x2 pk = *(LAS const u32x2*)(pl + s * 16 + 4 * gl);
                        const float p0 = bflo(pk[0]), p1 = bfhi(pk[0]), p2 = bflo(pk[1]), p3 = bfhi(pk[1]);
                        float vf[8]; unpack8(vv, vf);
#pragma unroll
                        for (int e = 0; e < 8; ++e) { o[0][e] += p0 * vf[e]; o[1][e] += p1 * vf[e]; o[2][e] += p2 * vf[e]; o[3][e] += p3 * vf[e]; }
                    }
#pragma unroll
                    for (int hl = 0; hl < 4; ++hl) { const float inv = invs[4 * gl + hl];
#pragma unroll
                        for (int e = 0; e < 8; ++e) o[hl][e] *= inv;
                        if (repc == DSA_REP_C - 1) *(u32x4*)(q1 + (size_t)t * 2048 + (4 * gl + hl) * 128 + (lane & 15) * 8) = pack8(o[hl]); }
                }
                wave_sync();
                }
            }
            __syncthreads();
        }
}
#ifndef MIXER_STAGE
#define MIXER_STAGE 2
#endif
__device__ __forceinline__ void zero_fill(bf16_t* p, size_t n8, int kwid) {
    u32x4 z; z.x = z.y = z.z = z.w = 0u;
    for (size_t i = (size_t)blockIdx.x * 512 + tid_op(kwid); i < n8; i += (size_t)gridDim.x * 512) ((u32x4*)p)[i] = z;
}

#define WSB(m) ((bf16_t*)(ws + (size_t)(m) * MiB))
#define WSF(m) ((float*)(ws + (size_t)(m) * MiB))
__device__ __forceinline__ void gbar(unsigned* ctr, unsigned& target, int kwid) {
    asm volatile("s_waitcnt vmcnt(0) lgkmcnt(0)" ::: "memory");
    __syncthreads();
    target += gridDim.x;
    if (tid_op(kwid) == 0) {
        __builtin_amdgcn_fence(__ATOMIC_RELEASE, "agent");
        asm volatile("s_waitcnt vmcnt(0)" ::: "memory");
        __hip_atomic_fetch_add(ctr, 1u, __ATOMIC_RELAXED, __HIP_MEMORY_SCOPE_AGENT);
        while (__hip_atomic_load(ctr, __ATOMIC_RELAXED, __HIP_MEMORY_SCOPE_AGENT) < target) __builtin_amdgcn_s_sleep(1);
        __builtin_amdgcn_fence(__ATOMIC_ACQUIRE, "agent");
        asm volatile("s_waitcnt vmcnt(0)" ::: "memory");
    }
    __syncthreads();
}
#define GSYNC() gbar(bctr, btarget, kwid)
template <int L> __device__ __forceinline__ void layer_body(const KP& p, unsigned char* ws, LAS unsigned char* lds, unsigned* bctr, unsigned& btarget, int& tb, const int kwid) {
        constexpr int oA_o = L ? 49 : 369, Ko = L ? 2048 : 4096, oWo = L ? 21 : 113, oY1 = 241, oX1 = L ? 113 : 49;
        constexpr int oWgu = L ? 497 : 129, oG = L ? 177 : 241, oU = L ? 337 : 401, oWd = L ? 537 : 169, oY2 = L ? 177 : 241, oX2 = 49;
        constexpr int oPb = L ? 38 : 593, oWpp = L ? 37 : 197, oPP = L ? 369 : 433, oWpg = L ? 29 : 189, oX2F = L ? 241 : 305;
        if constexpr (L == 0) {
            { EpiRoute e = mkroute(); e.nseg = 4;
              e.seg[0] = mkseg(WSB(113), 8, 2 * 8192, 16 * 8192, 128, 8192);
              e.seg[1] = mkseg(WSB(177), 16, 2 * 8192, 16 * 8192, 128, 8192);
              e.seg[2] = mkseg(WSB(241), 32, 2 * 8192, 32 * 8192, 128, 8192);
              e.seg[3] = mkseg(WSB(369), 48, 256, 64 * 4096, 4096, 128);
              e.halo = WSB(581); e.halo_pn = 32; e.fpn = 48;
              e.ft0.ptr = WSF(577); e.ft0.lc0 = 0; e.ft0.lc1 = 64; e.ft0.ld = 64; e.ft0.scale = 1.f;
              run_gemm(lds, kwid, WSB(49), WSB(0), 12544, 2048, e); }
            GSYNC();
#if MIXER_STAGE >= 1
#ifdef PROBE_G1
            gdn_g1(p, ws, lds, kwid, true);
            __syncthreads();
#endif
            gdn_g1(p, ws, lds, kwid);
            GSYNC();
#ifdef PROBE_G2
            gdn_g2(ws, lds, kwid, true);
            __syncthreads();
#endif
            gdn_g2(ws, lds, kwid);
            GSYNC();
            gdn_g3(p.in[6], WSB(241), WSB(369), kwid);
#else
            zero_fill(WSB(369), (size_t)T * 4096 / 8, kwid);
#endif
            convT_tiles(p.in[7], 4096, 2048, 2048, WSB(113), (LAS float*)lds, tb, kwid);
            convT_tiles(p.in[15], 2048, 5120, 5120, WSB(129), (LAS float*)lds, tb, kwid);
            convT_tiles(p.in[16], 2048, 5120, 5120, WSB(149), (LAS float*)lds, tb, kwid);
            convT_tiles(p.in[18], 5120, 2048, 2048, WSB(169), (LAS float*)lds, tb, kwid);
            convT_tiles(p.in[22], 2048, 2048, 2048, WSB(189), (LAS float*)lds, tb, kwid);
            convT_tiles(p.in[21], 256, 2048, 2048, WSB(197), (LAS float*)lds, tb, kwid);
            cvt_bf16(p.in[1], WSB(593), (size_t)T * 256 / 8, kwid);
            GSYNC();
        } else {
            { EpiRoute e = mkroute(); e.nseg = 4;
              e.seg[0] = mkseg(WSB(49), 8, 256, 64 * 2048, 2048, 128);
              e.seg[1] = mkseg(WSB(177), 10, 256, 64 * 512, 512, 128);
              e.seg[2] = mkseg(WSB(193), 12, 256, 64 * 512, 512, 128);
              e.seg[3] = mkseg(WSB(113), 20, 256, 64 * 2048, 2048, 128);
              e.fpn = 20;
              e.ft0.ptr = WSF(209); e.ft0.lc0 = 0; e.ft0.lc1 = 128; e.ft0.ld = 128; e.ft0.scale = 1.f;
              e.ft1.ptr = WSF(221); e.ft1.lc0 = 128; e.ft1.lc1 = 144; e.ft1.ld = 16; e.ft1.scale = 0.022097086912079608f;
              run_gemm(lds, kwid, WSB(557), WSB(0), 5376, 2048, e); }
            GSYNC();
#if MIXER_STAGE >= 2
            dsa_kiln(WSF(209), p.in[9], p.in[10], WSB(217), kwid);
            GSYNC();
            dsa_phase(WSB(113), WSB(217), WSF(221), WSB(49), WSB(177), WSB(193), WSF(241), p.in[12], lds, kwid);
#else
            zero_fill(WSB(49), (size_t)T * 2048 / 8, kwid);
#endif
            GSYNC();
        }
        { EpiResid f; f.rf = L ? nullptr : p.in[0]; f.rb = L ? WSB(557) : nullptr; f.Y = WSB(oY1);
          run_gemm(lds, kwid, WSB(oA_o), WSB(oWo), 2048, Ko, f); }
        GSYNC();
        ln_phase(WSB(oY1), p.in[13] + L * 2048, p.in[14] + L * 2048, WSB(oX1), nullptr, kwid);
        GSYNC();
        { EpiRoute e = mkroute(); e.nseg = 2;
          e.seg[0] = mkseg(WSB(oG), 20, 256, 64 * 5120, 5120, 128); e.seg[1] = mkseg(WSB(oU), 40, 256, 64 * 5120, 5120, 128);
          run_gemm(lds, kwid, WSB(oX1), WSB(oWgu), 10240, 2048, e); }
        GSYNC();
        convglu_phase(WSB(oG), WSB(oU), p.in[17] + (size_t)L * 3 * 5120, kwid);
        GSYNC();
        { EpiResid f; f.rf = nullptr; f.rb = WSB(oX1); f.Y = WSB(oY2); run_gemm(lds, kwid, WSB(oU), WSB(oWd), 2048, 5120, f); }
        GSYNC();
        ln_phase(WSB(oY2), p.in[19] + L * 2048, p.in[20] + L * 2048, WSB(oX2), WSF(oX2F), kwid);
        if constexpr (L == 0) {
            convT_tiles(p.in[8], 2048, 5264, 5376, WSB(0), (LAS float*)lds, tb, kwid);
            convT_tiles(p.in[11], 2048, 2048, 2048, WSB(21), (LAS float*)lds, tb, kwid);
            convT_tiles(p.in[22] + (size_t)2048 * 2048, 2048, 2048, 2048, WSB(29), (LAS float*)lds, tb, kwid);
            convT_tiles(p.in[21] + (size_t)256 * 2048, 256, 2048, 2048, WSB(37), (LAS float*)lds, tb, kwid);
            cvt_bf16(p.in[1] + (size_t)T * 256, WSB(38), (size_t)T * 256 / 8, kwid);
            convT_tiles(p.in[15] + (size_t)2048 * 5120, 2048, 5120, 5120, WSB(497), (LAS float*)lds, tb, kwid);
            convT_tiles(p.in[16] + (size_t)2048 * 5120, 2048, 5120, 5120, WSB(517), (LAS float*)lds, tb, kwid);
            convT_tiles(p.in[18] + (size_t)5120 * 2048, 5120, 2048, 2048, WSB(537), (LAS float*)lds, tb, kwid);
        }
        __syncthreads();
        { EpiRoute e = mkroute(); e.nseg = 1; e.seg[0] = mkseg(WSB(oPP), 8, 256, 64 * 2048, 2048, 128);
          int Kpp = 256; asm volatile("" : "+s"(Kpp));
          run_gemm(lds, kwid, WSB(oPb), WSB(oWpp), 2048, Kpp, e); }
        GSYNC();
        { EpiPle f; f.x2 = WSF(oX2F); f.PP = WSB(oPP); f.xb = L ? nullptr : WSB(557); f.fo = p.out;
          run_gemm(lds, kwid, WSB(oX2), WSB(oWpg), 2048, 2048, f); }
        GSYNC();
}

__global__ void __launch_bounds__(512, 2) fwd_kernel(KP p) {
    extern __shared__ __attribute__((aligned(16))) unsigned char lds_raw[];
    LAS unsigned char* lds = (LAS unsigned char*)lds_raw;
    cg::grid_group grid = cg::this_grid();
    unsigned char* ws = p.ws;
    int tb = 0;
    int kwid = __builtin_amdgcn_readfirstlane((int)(threadIdx.x >> 6)); asm volatile("" : "+s"(kwid));
    convT_tiles(p.in[2], 2048, 12352, 12544, WSB(0), (LAS float*)lds, tb, kwid);
    cvt_bf16(p.in[0], WSB(49), (size_t)T * 2048 / 8, kwid);
    unsigned* bctr = (unsigned*)(ws + 621 * MiB + 256); unsigned btarget = 0u;
    if (blockIdx.x == 0 && tid_op(kwid) == 0) __hip_atomic_store(bctr, 0u, __ATOMIC_RELAXED, __HIP_MEMORY_SCOPE_AGENT);
    __threadfence(); grid.sync();
    layer_body<0>(p, ws, lds, bctr, btarget, tb, kwid);
    layer_body<1>(p, ws, lds, bctr, btarget, tb, kwid);
}

extern "C" void kernel_launch(void* const* d_in, const int* in_sizes, int n_in, void* d_out, int out_size, void* d_ws, size_t ws_size, hipStream_t stream) {
    static int grid = 0;
    if (grid == 0) {
        if (n_in != 23 || out_size != T * DM || ws_size < 621 * MiB + 4096) { fprintf(stderr, "kernel_launch: unexpected problem (n_in %d, out %d, ws %zu); nothing launched\n", n_in, out_size, ws_size); grid = -1; return; }
        int dev = 0, cus = 0, per_cu = 0;
        hipGetDevice(&dev); hipDeviceGetAttribute(&cus, hipDeviceAttributeMultiprocessorCount, dev);
        if (hipFuncSetAttribute((const void*)fwd_kernel, hipFuncAttributeMaxDynamicSharedMemorySize, LDS_BYTES) != hipSuccess) { fprintf(stderr, "kernel_launch: hipFuncSetAttribute failed\n"); grid = -1; return; }
        if (hipOccupancyMaxActiveBlocksPerMultiprocessor(&per_cu, (const void*)fwd_kernel, 512, LDS_BYTES) != hipSuccess || per_cu < 1) { fprintf(stderr, "kernel_launch: occupancy query says %d\n", per_cu); per_cu = 1; }
        (void)hipGetLastError();
        grid = cus;
        if (grid > 256) grid = 256;
    }
    if (grid < 0) return;
    KP p{};
    for (int i = 0; i < 23; ++i) p.in[i] = (const float*)d_in[i];
    p.out = (float*)d_out; p.ws = (unsigned char*)d_ws;
    void* args[] = {&p};
    hipError_t e = hipLaunchCooperativeKernel((const void*)fwd_kernel, dim3(grid), dim3(512), args, LDS_BYTES, stream);
    if (e != hipSuccess) fprintf(stderr, "cooperative launch failed: %s (grid %d)\n", hipGetErrorString(e), grid);
}
```

```cpp
#include <hip/hip_runtime.h>
#include <hip/hip_cooperative_groups.h>
#include <cstdio>
namespace cg = cooperative_groups;
#define MIXER_STAGE 2
__device__ __forceinline__ int tid_op(int kwid);
namespace pg8 {
#define PG8_LAS __attribute__((address_space(3)))
typedef unsigned short bf16_t;
typedef short bf16x8 __attribute__((ext_vector_type(8)));
typedef float f32x4 __attribute__((ext_vector_type(4)));
typedef unsigned u32x4 __attribute__((ext_vector_type(4)));
constexpr int BM = 256, BK = 64, HALF = 128, HTB = HALF * BK * 2  , STAGE_BYTES = 8 * HTB, NXCD = 8, WGM = 8;

__host__ __device__ __forceinline__ int lds_byte(int r, int c) { const int st = (r >> 4) * 2 + (c >> 5), rr = r & 15, cc = c & 31, ob = rr * 64 + cc * 2; return st * 1024 + (ob ^ (((ob >> 9) & 1) << 5)); }
__host__ __device__ __forceinline__ void stage_rc(int b, int& R, int& C) { const int st = b / 1024, sb = b % 1024, swz = sb ^ (((sb >> 9) & 1) << 5); R = (st >> 1) * 16 + swz / 64; C = (st & 1) * 32 + (swz % 64) / 2; }
__host__ __device__ __forceinline__ int perm32(int rho) { const int n = rho >> 4, i = rho & 15; return 8 * (i >> 2) + 4 * n + (i & 3); }

struct Unit { int pm, pn; };
struct Gemm { const bf16_t* A; const bf16_t* Bt; int M, N, K; };

struct StaticOrder {
    int nM, nN, nwg, G, c;
    __host__ __device__ void init(int M, int N, int G_, int c_) { nM = M / BM; nN = N / BM; nwg = nM * nN; G = G_; c = c_; }
    __host__ __device__ bool next(int i, Unit& u) const {
        const long L = (long)i * G + c; if (L >= nwg) return false;
        int wgid = (int)L; { const int q = nwg / NXCD, r = nwg % NXCD, xcd = wgid % NXCD, off = wgid / NXCD; wgid = (xcd < r ? xcd * (q + 1) : r * (q + 1) + (xcd - r) * q) + off; }
        const int nig = WGM * nN, gid = wgid / nig, fm = gid * WGM, gsz = (nM - fm) < WGM ? (nM - fm) : WGM;
        u.pm = fm + ((wgid % nig) % gsz); u.pn = (wgid % nig) / gsz; return true;
    }
    __device__ __forceinline__ void a_ready(const Unit&) const {}
    __device__ __forceinline__ void done(const Unit&) const {}
};
template <class Epi, class Sched, bool STAMP = false>
__device__ __forceinline__ void gemm_phase(PG8_LAS unsigned char* lds, const Gemm g, const Sched& S, const Epi& E, unsigned long long* stamps, const int kwid) {
    const int tid = tid_op(kwid), wid = __builtin_amdgcn_readfirstlane(tid >> 6), lane = tid & 63, wr = wid >> 2, wc = wid & 3, fr = lane & 15, fq = lane >> 4;
    const int K = g.K, nt = K / BK;
    int ts_lo = 0, ts_hi = 0, nts = 0; const unsigned long long rt_entry = STAMP ? (unsigned long long)wall_clock64() : 0ull;
#define PG8_STAMP() do { if (STAMP && wid == 0 && nts < 64) { const unsigned long long _c = (unsigned long long)clock64(); \
        ts_lo = (lane == nts) ? (int)(unsigned)_c : ts_lo; ts_hi = (lane == nts) ? (int)(unsigned)(_c >> 32) : ts_hi; ++nts; } } while (0)
    PG8_STAMP();
    unsigned voffA[2], voffB[2];
#pragma unroll
    for (int i = 0; i < 2; ++i) { int R, C; stage_rc(tid * 16 + i * 8192, R, C); const int Rb = Epi::PERM ? ((R & ~31) + perm32(R & 31)) : R;
        voffA[i] = (unsigned)(R * K + C) * 2u; voffB[i] = (unsigned)(Rb * K + C) * 2u; }
    const size_t kstep = (size_t)(BK * 2);
    const size_t hstep = (size_t)HALF * K * 2;
    const size_t tstep = 2 * hstep;
    const unsigned ldsw = (unsigned)wid * 1024u;
    const int aoff = lds_byte(wr * 64 + fr, fq * 8), boff = lds_byte(wc * 32 + fr, fq * 8);
#define PG8_SA(b, h) (((b) * 2 + (h)) * HTB)
#define PG8_SB(b, h) ((4 + (b) * 2 + (h)) * HTB)
#define PG8_STAGE(bufoff, gbase, voff) do { _Pragma("unroll") for (int _i = 0; _i < 2; ++_i) \
        __builtin_amdgcn_global_load_lds((const unsigned*)((const char*)(gbase) + (voff)[_i]), (PG8_LAS unsigned*)(lds + (bufoff) + ldsw + _i * 8192), 16, 0, 0); } while (0)
#define PG8_LDA(dst, b, h) do { _Pragma("unroll") for (int m = 0; m < 4; ++m) _Pragma("unroll") for (int k = 0; k < 2; ++k) dst[m][k] = *(const PG8_LAS bf16x8*)(lds + PG8_SA(b, h) + aoff + m * 2048 + k * 1024); } while (0)
#define PG8_LDB(dst, b, h) do { _Pragma("unroll") for (int n = 0; n < 2; ++n) _Pragma("unroll") for (int k = 0; k < 2; ++k) dst[n][k] = *(const PG8_LAS bf16x8*)(lds + PG8_SB(b, h) + boff + n * 2048 + k * 1024); } while (0)
#define PG8_MMA(ai, bj, At, Bt) do { __builtin_amdgcn_s_setprio(1); _Pragma("unroll") for (int m = 0; m < 4; ++m) _Pragma("unroll") for (int n = 0; n < 2; ++n) _Pragma("unroll") for (int k = 0; k < 2; ++k) \
        acc[ai][bj][m][n] = __builtin_amdgcn_mfma_f32_16x16x32_bf16(Bt[n][k], At[m][k], acc[ai][bj][m][n], 0, 0, 0); __builtin_amdgcn_s_setprio(0); } while (0)
#define PG8_WAIT_V(n) asm volatile("s_waitcnt vmcnt(" #n ")" ::: "memory")
#define PG8_WAIT_L(n) asm volatile("s_waitcnt lgkmcnt(" #n ")" ::: "memory")
#define PG8_BAR __builtin_amdgcn_s_barrier()
#define PG8_SCHED __builtin_amdgcn_sched_barrier(0)
    Unit cur, nxt; int ui = 0;
    if (!S.next(0, cur)) return;
    f32x4 acc[2][2][4][2];
#pragma unroll
    for (int a = 0; a < 2; ++a)
#pragma unroll
        for (int b = 0; b < 2; ++b)
#pragma unroll
            for (int m = 0; m < 4; ++m)
#pragma unroll
                for (int n = 0; n < 2; ++n) acc[a][b][m][n] = (f32x4){0.f, 0.f, 0.f, 0.f};
    bf16x8 At[4][2], B0[2][2], B1[2][2];
    const char* cA = (const char*)g.A + (size_t)cur.pm * tstep; const char* cB = (const char*)g.Bt + (size_t)cur.pn * tstep;
    S.a_ready(cur);
    PG8_STAGE(PG8_SB(0, 0), cB, voffB); PG8_STAGE(PG8_SA(0, 0), cA, voffA); PG8_STAGE(PG8_SB(0, 1), cB + hstep, voffB); PG8_STAGE(PG8_SA(0, 1), cA + hstep, voffA);
    if (wr == 1) PG8_BAR;
    PG8_WAIT_V(4); PG8_BAR;
    PG8_STAGE(PG8_SB(1, 0), cB + kstep, voffB); PG8_STAGE(PG8_SA(1, 0), cA + kstep, voffA); PG8_STAGE(PG8_SB(1, 1), cB + hstep + kstep, voffB);
    PG8_WAIT_V(6); PG8_BAR;
    PG8_STAMP();
    for (;;) {
        const bool has_next = S.next(ui + 1, nxt);
        const char* nA = has_next ? (const char*)g.A + (size_t)nxt.pm * tstep : cA; const char* nB = has_next ? (const char*)g.Bt + (size_t)nxt.pn * tstep : cB;
        for (int t = 0; t < nt; t += 2) {
            const bool last = (t == nt - 2);
            const char* a1 = cA + (size_t)(t + 1) * kstep;
            const char* a2 = last ? nA : cA + (size_t)(t + 2) * kstep; const char* b2 = last ? nB : cB + (size_t)(t + 2) * kstep;
            const char* a3 = a2 + kstep; const char* b3 = b2 + kstep;
            if (last && has_next) S.a_ready(nxt);
            PG8_LDB(B0, 0, 0); PG8_SCHED; PG8_LDA(At, 0, 0); PG8_STAGE(PG8_SA(1, 1), a1 + hstep, voffA);
            PG8_WAIT_L(8); PG8_BAR; PG8_WAIT_L(0); PG8_MMA(0, 0, At, B0); PG8_BAR; PG8_SCHED;
            PG8_LDB(B1, 0, 1); PG8_STAGE(PG8_SB(0, 0), b2, voffB);
            PG8_BAR; PG8_WAIT_L(0); PG8_MMA(0, 1, At, B1); PG8_BAR;
            PG8_LDA(At, 0, 1); PG8_STAGE(PG8_SA(0, 0), a2, voffA);
            PG8_BAR; PG8_WAIT_L(0); PG8_MMA(1, 0, At, B0); PG8_BAR; PG8_SCHED;
            PG8_STAGE(PG8_SB(0, 1), b2 + hstep, voffB);
            PG8_WAIT_V(6); PG8_BAR; PG8_MMA(1, 1, At, B1); PG8_BAR;
            PG8_LDB(B0, 1, 0); PG8_SCHED; PG8_LDA(At, 1, 0); PG8_STAGE(PG8_SA(0, 1), a2 + hstep, voffA);
            PG8_WAIT_L(8); PG8_BAR; PG8_WAIT_L(0); PG8_MMA(0, 0, At, B0); PG8_BAR; PG8_SCHED;
            PG8_LDB(B1, 1, 1); PG8_STAGE(PG8_SB(1, 0), b3, voffB);
            PG8_BAR; PG8_WAIT_L(0); PG8_MMA(0, 1, At, B1); PG8_BAR;
            PG8_LDA(At, 1, 1); PG8_STAGE(PG8_SA(1, 0), a3, voffA);
            PG8_BAR; PG8_WAIT_L(0); PG8_MMA(1, 0, At, B0); PG8_BAR; PG8_SCHED;
            PG8_STAGE(PG8_SB(1, 1), b3 + hstep, voffB);
            PG8_WAIT_V(6); PG8_BAR; PG8_MMA(1, 1, At, B1); PG8_BAR;
        }
        PG8_STAMP();
        if constexpr (!Epi::AFTER_DRAIN) { E(acc, cur, wr, wc, fr, fq); S.done(cur); }
        PG8_STAMP();
        if (!has_next) break;
#pragma unroll
        for (int a = 0; a < 2; ++a)
#pragma unroll
            for (int b = 0; b < 2; ++b)
#pragma unroll
                for (int m = 0; m < 4; ++m)
#pragma unroll
                    for (int n = 0; n < 2; ++n) acc[a][b][m][n] = (f32x4){0.f, 0.f, 0.f, 0.f};
        cur = nxt; cA = nA; cB = nB; ++ui;
    }
    PG8_WAIT_V(0);
    if (wr == 0) PG8_BAR;
    PG8_BAR;
    if constexpr (Epi::AFTER_DRAIN) { E.fused(acc, cur, wr, wc, fr, fq, lds, wid, lane); S.done(cur); }
    PG8_STAMP();
    if (STAMP && wid == 0) { stamps[lane] = lane < nts ? (((unsigned long long)(unsigned)ts_hi << 32) | (unsigned)ts_lo) : 0ull;
        if (lane == 62) stamps[62] = rt_entry; if (lane == 63) stamps[63] = (unsigned long long)wall_clock64(); }
#undef PG8_STAMP
#undef PG8_SA
#undef PG8_SB
#undef PG8_STAGE
#undef PG8_LDA
#undef PG8_LDB
#undef PG8_MMA
#undef PG8_WAIT_V
#undef PG8_WAIT_L
#undef PG8_BAR
#undef PG8_SCHED
}
}

#include <cstdio>
#include <ctime>
#include <cstdlib>
#include <cstring>
#include <cmath>
#include <vector>
#include <algorithm>
#define CK(x) do { hipError_t e_ = (x); if (e_ != hipSuccess) { fprintf(stderr, "HIP %s:%d %s\n", __FILE__, __LINE__, hipGetErrorString(e_)); exit(2); } } while (0)
using pg8::bf16_t; using pg8::bf16x8; using pg8::f32x4; using pg8::u32x4;
typedef float f32x16 __attribute__((ext_vector_type(16)));
typedef unsigned u32x2 __attribute__((ext_vector_type(2)));
#define LAS PG8_LAS
constexpr int T = 16384, DM = 2048;
constexpr size_t MiB = 1ull << 20;
constexpr int LDS_BYTES = 152576;
constexpr float DN_ALPHA = 1.4142135623730951f;

struct KP { const float* in[23]; float* out; unsigned char* ws; };

typedef float f32x2c __attribute__((ext_vector_type(2)));
typedef __bf16 bf16x2c __attribute__((ext_vector_type(2)));
__device__ __forceinline__ unsigned pack2(float lo, float hi) { const f32x2c v = {lo, hi}; return __builtin_bit_cast(unsigned, __builtin_convertvector(v, bf16x2c)); }
__device__ __forceinline__ unsigned short f2bf(float f) { return (unsigned short)(pack2(f, 0.f) & 0xffffu); }
__device__ __forceinline__ float bf2f(unsigned short b) { return __uint_as_float(((unsigned)b) << 16); }
__device__ __forceinline__ float bflo(unsigned w) { return __uint_as_float(w << 16); }
__device__ __forceinline__ float bfhi(unsigned w) { return __uint_as_float(w & 0xffff0000u); }
__device__ __forceinline__ void unpack8(const u32x4 v, float* f) { f[0] = bflo(v.x); f[1] = bfhi(v.x); f[2] = bflo(v.y); f[3] = bfhi(v.y); f[4] = bflo(v.z); f[5] = bfhi(v.z); f[6] = bflo(v.w); f[7] = bfhi(v.w); }
__device__ __forceinline__ u32x4 pack8(const float* f) { u32x4 w; w.x = pack2(f[0], f[1]); w.y = pack2(f[2], f[3]); w.z = pack2(f[4], f[5]); w.w = pack2(f[6], f[7]); return w; }
__device__ __forceinline__ float wave_sum(float v) { v += __shfl_xor(v, 32); v += __shfl_xor(v, 16); v += __shfl_xor(v, 8); v += __shfl_xor(v, 4); v += __shfl_xor(v, 2); v += __shfl_xor(v, 1); return v; }
__device__ __forceinline__ float wave_max(float v) { v = fmaxf(v, __shfl_xor(v, 32)); v = fmaxf(v, __shfl_xor(v, 16)); v = fmaxf(v, __shfl_xor(v, 8)); v = fmaxf(v, __shfl_xor(v, 4)); v = fmaxf(v, __shfl_xor(v, 2)); v = fmaxf(v, __shfl_xor(v, 1)); return v; }
__device__ __forceinline__ void wave_sync() { __builtin_amdgcn_fence(__ATOMIC_SEQ_CST, "wavefront"); __builtin_amdgcn_wave_barrier(); __builtin_amdgcn_fence(__ATOMIC_SEQ_CST, "wavefront"); }
__device__ __forceinline__ int tid_op(int kwid) {
    int l; asm volatile("v_mbcnt_lo_u32_b32 %0, -1, 0\n\tv_mbcnt_hi_u32_b32 %0, -1, %0" : "=v"(l));
    return (kwid << 6) | l; }
__device__ __forceinline__ float bperm_f(int srclane, float v) { return __int_as_float(__builtin_amdgcn_ds_bpermute(srclane << 2, __float_as_int(v))); }
__device__ __forceinline__ int bperm_i(int srclane, int v) { return __builtin_amdgcn_ds_bpermute(srclane << 2, v); }
__device__ __forceinline__ float wsum_l(float v, int ln) { v += bperm_f(ln ^ 32, v); v += bperm_f(ln ^ 16, v); v += bperm_f(ln ^ 8, v); v += bperm_f(ln ^ 4, v); v += bperm_f(ln ^ 2, v); v += bperm_f(ln ^ 1, v); return v; }
__device__ __forceinline__ float wmax_l(float v, int ln) { v = fmaxf(v, bperm_f(ln ^ 32, v)); v = fmaxf(v, bperm_f(ln ^ 16, v)); v = fmaxf(v, bperm_f(ln ^ 8, v)); v = fmaxf(v, bperm_f(ln ^ 4, v)); v = fmaxf(v, bperm_f(ln ^ 2, v)); v = fmaxf(v, bperm_f(ln ^ 1, v)); return v; }
__device__ __forceinline__ float siluf(float x) { return x * __builtin_amdgcn_rcpf(1.0f + __expf(-x)); }
__device__ __forceinline__ float sigmoidf_(float x) { return __builtin_amdgcn_rcpf(1.0f + __expf(-x)); }

__device__ __forceinline__ void convT_tiles(const float* __restrict__ in, int K, int N, int Npad, bf16_t* __restrict__ out, LAS float* tile, int& tbase, int kwid) {
    const int G = gridDim.x, tid = tid_op(kwid);
    const int ntn = Npad >> 8, ntiles = (K >> 6) * ntn;
    int first = ((int)blockIdx.x - tbase) % G; if (first < 0) first += G;
    for (int t = first; t < ntiles; t += G) {
        const int kt = t / ntn, nt = t - kt * ntn, k0 = kt << 6, n0 = nt << 8;
        float4 v[8];
#pragma unroll
        for (int i = 0; i < 8; ++i) {
            const int e = tid + i * 512, kk = e >> 6, n4 = (e & 63) << 2, n = n0 + n4;
            v[i] = make_float4(0.f, 0.f, 0.f, 0.f);
            if (n < N) v[i] = *(const float4*)(in + (size_t)(k0 + kk) * N + n);
        }
#pragma unroll
        for (int i = 0; i < 8; ++i) {
            const int e = tid + i * 512, kk = e >> 6, n4 = (e & 63) << 2;
            LAS float* d = tile + kk * 257 + n4; d[0] = v[i].x; d[1] = v[i].y; d[2] = v[i].z; d[3] = v[i].w;
        }
        __syncthreads();
#pragma unroll
        for (int i = 0; i < 4; ++i) {
            const int e = tid + i * 512, n = e >> 3, k8 = (e & 7) << 3; float f[8];
#pragma unroll
            for (int j = 0; j < 8; ++j) f[j] = tile[(k8 + j) * 257 + n];
            *(u32x4*)(out + (size_t)(n0 + n) * K + k0 + k8) = pack8(f);
        }
        __syncthreads();
    }
    tbase = (tbase + ntiles) % G;
}
__device__ __forceinline__ void cvt_bf16(const float* __restrict__ in, bf16_t* __restrict__ out, size_t n8, int kwid) {
    for (size_t i = (size_t)blockIdx.x * 512 + tid_op(kwid); i < n8; i += (size_t)gridDim.x * 512) {
        const float4 a = ((const float4*)in)[2 * i], b = ((const float4*)in)[2 * i + 1];
        u32x4 w; w.x = pack2(a.x, a.y); w.y = pack2(a.z, a.w); w.z = pack2(b.x, b.y); w.w = pack2(b.z, b.w);
        ((u32x4*)out)[i] = w;
    }
}

__device__ __forceinline__ void ln_phase(const bf16_t* Y, const float* __restrict__ g, const float* __restrict__ b, bf16_t* xb, float* xf, int kwid) {
    const int tidx = tid_op(kwid), lane = tidx & 63, gw = blockIdx.x * 8 + (tidx >> 6), nw = gridDim.x * 8;
    for (int row = gw; row < T; row += nw) {
        const u32x4* yr = (const u32x4*)(Y + (size_t)row * DM);
        float v[4][8]; float s = 0.f;
#pragma unroll
        for (int i = 0; i < 4; ++i) { unpack8(yr[i * 64 + lane], v[i]);
#pragma unroll
            for (int k = 0; k < 8; ++k) s += v[i][k]; }
        s = wave_sum(s); const float mean = s * (1.0f / 2048.0f);
        float q = 0.f;
#pragma unroll
        for (int i = 0; i < 4; ++i)
#pragma unroll
            for (int k = 0; k < 8; ++k) { const float d = v[i][k] - mean; q += d * d; }
        q = wave_sum(q); const float rstd = rsqrtf(q * (1.0f / 2048.0f) + 1e-5f);
#pragma unroll
        for (int i = 0; i < 4; ++i) {
            const int c = (i * 64 + lane) * 8; float o[8];
            const float4 g0 = *(const float4*)(g + c), g1 = *(const float4*)(g + c + 4), b0 = *(const float4*)(b + c), b1 = *(const float4*)(b + c + 4);
            o[0] = (v[i][0] - mean) * rstd * g0.x + b0.x; o[1] = (v[i][1] - mean) * rstd * g0.y + b0.y; o[2] = (v[i][2] - mean) * rstd * g0.z + b0.z; o[3] = (v[i][3] - mean) * rstd * g0.w + b0.w;
            o[4] = (v[i][4] - mean) * rstd * g1.x + b1.x; o[5] = (v[i][5] - mean) * rstd * g1.y + b1.y; o[6] = (v[i][6] - mean) * rstd * g1.z + b1.z; o[7] = (v[i][7] - mean) * rstd * g1.w + b1.w;
            *(u32x4*)(xb + (size_t)row * DM + c) = pack8(o);
            if (xf) { f32x4 f0 = {o[0], o[1], o[2], o[3]}, f1 = {o[4], o[5], o[6], o[7]}; *(f32x4*)(xf + (size_t)row * DM + c) = f0; *(f32x4*)(xf + (size_t)row * DM + c + 4) = f1; }
        }
    }
}

__device__ __forceinline__ void convglu_phase(const bf16_t* Gm, bf16_t* U, const float* __restrict__ cw, int kwid) {
    const int tidx = tid_op(kwid), lane = tidx & 63, gw = blockIdx.x * 8 + (tidx >> 6), nw = gridDim.x * 8;
    for (int u = gw; u < 2560; u += nw) {
        const int cgp = u % 10, rb = u / 10, c0 = cgp * 512 + lane * 8, r0 = rb * 64;
        float w0[8], w1[8], w2[8], p2[8], p1[8];
#pragma unroll
        for (int k = 0; k < 8; ++k) { w0[k] = cw[c0 + k]; w1[k] = cw[5120 + c0 + k]; w2[k] = cw[10240 + c0 + k]; p2[k] = 0.f; p1[k] = 0.f; }
        if (r0 > 0) { unpack8(*(const u32x4*)(Gm + (size_t)(r0 - 2) * 5120 + c0), p2); unpack8(*(const u32x4*)(Gm + (size_t)(r0 - 1) * 5120 + c0), p1); }
        for (int r = r0; r < r0 + 64; r += 4) {
            u32x4 gq[4], uq[4];
#pragma unroll
            for (int q = 0; q < 4; ++q) { gq[q] = *(const u32x4*)(Gm + (size_t)(r + q) * 5120 + c0); uq[q] = *(const u32x4*)(U + (size_t)(r + q) * 5120 + c0); }
#pragma unroll
            for (int q = 0; q < 4; ++q) {
                float gv[8], uv[8], hv[8];
                unpack8(gq[q], gv); unpack8(uq[q], uv);
#pragma unroll
                for (int k = 0; k < 8; ++k) { const float gate = w0[k] * p2[k] + w1[k] * p1[k] + w2[k] * gv[k]; hv[k] = siluf(gate) * uv[k]; p2[k] = p1[k]; p1[k] = gv[k]; }
                *(u32x4*)(U + (size_t)(r + q) * 5120 + c0) = pack8(hv);
            }
        }
    }
}

__device__ __forceinline__ uint2 pk4(const f32x4 v) { uint2 w; w.x = pack2(v[0], v[1]); w.y = pack2(v[2], v[3]); return w; }
struct Seg { bf16_t* ptr; int pn1; int pn_stride; int chunk_stride; int row_stride; int bj_stride; };
struct F32Tgt { float* ptr; int lc0, lc1, ld; float scale; };
struct EpiRoute {
    static constexpr bool PERM = false, AFTER_DRAIN = false;
    Seg seg[4]; int nseg; bf16_t* halo; int halo_pn; int fpn; F32Tgt ft0, ft1;
    static __device__ __forceinline__ void f32store(const F32Tgt& t, const f32x4 (&acc)[2][2][4][2], int row0, int lc0) {
        if (!t.ptr) return;
#pragma unroll
        for (int bj = 0; bj < 2; ++bj)
#pragma unroll
            for (int n = 0; n < 2; ++n) {
                const int lc = lc0 + bj * 128 + n * 16;
                if (lc >= t.lc0 && lc < t.lc1) {
#pragma unroll
                    for (int ai = 0; ai < 2; ++ai)
#pragma unroll
                        for (int m = 0; m < 4; ++m) *(f32x4*)(t.ptr + (size_t)(row0 + ai * 128 + m * 16) * t.ld + (lc - t.lc0)) = acc[ai][bj][m][n] * t.scale;
                }
            }
    }
    __device__ __forceinline__ void operator()(const f32x4 (&acc)[2][2][4][2], const pg8::Unit& u, int wr, int wc, int fr, int fq) const {
        const int row0 = u.pm * 256 + wr * 64 + fr, lc0 = wc * 32 + 4 * fq, pn = u.pn;
        if (pn == fpn) { f32store(ft0, acc, row0, lc0); f32store(ft1, acc, row0, lc0); return; }
        Seg sg = seg[0]; int pnb = 0;
        if (nseg > 1 && pn >= seg[0].pn1) { sg = seg[1]; pnb = seg[0].pn1; }
        if (nseg > 2 && pn >= seg[1].pn1) { sg = seg[2]; pnb = seg[1].pn1; }
        if (nseg > 3 && pn >= seg[2].pn1) { sg = seg[3]; pnb = seg[2].pn1; }
        if (pn >= sg.pn1) return;
        bf16_t* base = sg.ptr + (size_t)(pn - pnb) * sg.pn_stride + lc0;
        const int cs = sg.chunk_stride, rs = sg.row_stride, bs = sg.bj_stride;
#pragma unroll
        for (int ai = 0; ai < 2; ++ai)
#pragma unroll
            for (int m = 0; m < 4; ++m) {
                const int row = row0 + ai * 128 + m * 16;
                bf16_t* rp = base + (size_t)(row >> 6) * cs + (row & 63) * rs;
#pragma unroll
                for (int bj = 0; bj < 2; ++bj)
#pragma unroll
                    for (int n = 0; n < 2; ++n) *(uint2*)(rp + bj * bs + n * 16) = pk4(acc[ai][bj][m][n]);
            }
        if (halo && pn < halo_pn && fr >= 13) {
#pragma unroll
            for (int ai = 0; ai < 2; ++ai) {
                const int row = row0 + ai * 128 + 48;
                bf16_t* hp = halo + ((size_t)(row >> 6) * 3 + (fr - 13)) * 8192 + pn * 256 + lc0;
#pragma unroll
                for (int bj = 0; bj < 2; ++bj)
#pragma unroll
                    for (int n = 0; n < 2; ++n) *(uint2*)(hp + bj * 128 + n * 16) = pk4(acc[ai][bj][3][n]);
            }
        }
    }
};
struct EpiResid {
    static constexpr bool PERM = false, AFTER_DRAIN = false;
    const float* rf; const bf16_t* rb; bf16_t* Y;
    __device__ __forceinline__ void operator()(const f32x4 (&acc)[2][2][4][2], const pg8::Unit& u, int wr, int wc, int fr, int fq) const {
        const int row0 = u.pm * 256 + wr * 64 + fr, col0 = u.pn * 256 + wc * 32 + 4 * fq;
#pragma unroll
        for (int ai = 0; ai < 2; ++ai)
#pragma unroll
            for (int m = 0; m < 4; ++m) {
                const size_t o = (size_t)(row0 + ai * 128 + m * 16) * DM + col0;
#pragma unroll
                for (int bj = 0; bj < 2; ++bj)
#pragma unroll
                    for (int n = 0; n < 2; ++n) {
                        f32x4 r;
                        if (rf) r = *(const f32x4*)(rf + o + bj * 128 + n * 16);
                        else { const uint2 w = *(const uint2*)(rb + o + bj * 128 + n * 16); r[0] = bflo(w.x); r[1] = bfhi(w.x); r[2] = bflo(w.y); r[3] = bfhi(w.y); }
                        *(uint2*)(Y + o + bj * 128 + n * 16) = pk4(r * DN_ALPHA + acc[ai][bj][m][n]);
                    }
            }
    }
};
struct EpiPle {
    static constexpr bool PERM = false, AFTER_DRAIN = false;
    const float* x2; const bf16_t* PP; bf16_t* xb; float* fo;
    __device__ __forceinline__ void operator()(const f32x4 (&acc)[2][2][4][2], const pg8::Unit& u, int wr, int wc, int fr, int fq) const {
        const int row0 = u.pm * 256 + wr * 64 + fr, col0 = u.pn * 256 + wc * 32 + 4 * fq;
#pragma unroll
        for (int ai = 0; ai < 2; ++ai)
#pragma unroll
            for (int m = 0; m < 4; ++m) {
                const size_t o = (size_t)(row0 + ai * 128 + m * 16) * DM + col0;
#pragma unroll
                for (int bj = 0; bj < 2; ++bj)
#pragma unroll
                    for (int n = 0; n < 2; ++n) {
                        const size_t oo = o + bj * 128 + n * 16; const f32x4 v = acc[ai][bj][m][n];
                        const f32x4 x = *(const f32x4*)(x2 + oo); const uint2 w = *(const uint2*)(PP + oo);
                        f32x4 r; r[0] = x[0] + sigmoidf_(v[0]) * bflo(w.x); r[1] = x[1] + sigmoidf_(v[1]) * bfhi(w.x); r[2] = x[2] + sigmoidf_(v[2]) * bflo(w.y); r[3] = x[3] + sigmoidf_(v[3]) * bfhi(w.y);
                        if (xb) *(uint2*)(xb + oo) = pk4(r); else *(f32x4*)(fo + oo) = r;
                    }
            }
    }
};
template <class E> __device__ __forceinline__ void run_gemm(LAS unsigned char* lds, int kwid, const bf16_t* A, const bf16_t* Bt, int N, int K, const E& e) {
    pg8::Gemm g; g.A = A; g.Bt = Bt; g.M = T; g.N = N; g.K = K;
    pg8::StaticOrder S; S.init(T, N, (int)gridDim.x, (int)blockIdx.x);
    pg8::gemm_phase<E, pg8::StaticOrder, false>(lds, g, S, e, nullptr, kwid);
}
__device__ __forceinline__ Seg mkseg(bf16_t* p, int pn1, int pns, int cs, int rs, int bs) { Seg s; s.ptr = p; s.pn1 = pn1; s.pn_stride = pns; s.chunk_stride = cs; s.row_stride = rs; s.bj_stride = bs; return s; }
__device__ __forceinline__ EpiRoute mkroute() { EpiRoute e; e.nseg = 0; e.halo = nullptr; e.halo_pn = 0; e.fpn = -1; e.ft0.ptr = nullptr; e.ft1.ptr = nullptr;
    for (int i = 0; i < 4; ++i) e.seg[i] = mkseg(nullptr, 0, 0, 0, 0, 0);
    e.ft0.lc0 = 0; e.ft0.lc1 = 0; e.ft0.ld = 0; e.ft0.scale = 1.f; e.ft1 = e.ft0; return e; }
__device__ __forceinline__ bf16_t* gdn_wptr(unsigned char* ws, int h) { return (bf16_t*)(ws + (h < 12 ? (size_t)h * 4 * MiB : (size_t)(497 + (h - 12) * 4) * MiB)); }

__device__ __forceinline__ void gdn_g1(const KP& p, unsigned char* ws, LAS unsigned char* ldsb, int kwid, const bool dry = false) {
    LAS float* qs = (LAS float*)ldsb; LAS float* ks = qs + 64 * 129;
    LAS bf16_t* Am = (LAS bf16_t*)qs; LAS float* KKs = ks; LAS float* QKs = KKs + 64 * 64;
    LAS bf16_t* qb = (LAS bf16_t*)(ldsb + 66048); LAS bf16_t* kb = qb + 64 * 136;
    LAS float* gcs = (LAS float*)(ldsb + 66048 + 34816); LAS float* bts = gcs + 128;
    bf16_t* Qb = (bf16_t*)(ws + 113 * MiB); bf16_t* Kb = (bf16_t*)(ws + 177 * MiB); bf16_t* Vb = (bf16_t*)(ws + 241 * MiB);
    float* AB = (float*)(ws + 577 * MiB); const bf16_t* HALO = (const bf16_t*)(ws + 581 * MiB); bf16_t* qkd = (bf16_t*)(ws + 49 * MiB); float* gcb = (float*)(ws + 601 * MiB);
    const float* convw = p.in[3]; const float* a_log = p.in[4]; const float* dt_bias = p.in[5];
    for (int unit = blockIdx.x; unit < 4096; unit += gridDim.x) {
        const int tid = tid_op(kwid), lane = tid & 63, wv = kwid;
        const int j = unit & 15, n = unit >> 4;
        {
            const int c = tid & 127, rg = tid >> 7;
#pragma unroll
            for (int which = 0; which < 2; ++which) {
                const bf16_t* src = (which ? Kb : Qb) + (size_t)(n * 16 + j) * 8192 + c;
                const int ch = which * 2048 + j * 128 + c;
                const float w0 = convw[ch], w1 = convw[8192 + ch], w2 = convw[2 * 8192 + ch], w3 = convw[3 * 8192 + ch];
                float xm3 = 0.f, xm2 = 0.f, xm1 = 0.f;
                if (rg > 0) { xm3 = bf2f(src[(rg * 16 - 3) * 128]); xm2 = bf2f(src[(rg * 16 - 2) * 128]); xm1 = bf2f(src[(rg * 16 - 1) * 128]); }
                else if (n > 0) { const bf16_t* hp = HALO + (size_t)(n - 1) * 3 * 8192 + ch; xm3 = bf2f(hp[0]); xm2 = bf2f(hp[8192]); xm1 = bf2f(hp[2 * 8192]); }
                LAS float* dst = which ? ks : qs;
#pragma unroll
                for (int i = 0; i < 16; ++i) {
                    const float x0 = bf2f(src[(rg * 16 + i) * 128]);
                    const float y = w0 * xm3 + w1 * xm2 + w2 * xm1 + w3 * x0;
                    dst[(rg * 16 + i) * 129 + c] = siluf(y);
                    xm3 = xm2; xm2 = xm1; xm1 = x0;
                }
            }
        }
        __syncthreads();
        int lane_u = lane; asm volatile("" : "+v"(lane_u));
#pragma unroll
        for (int rr = 0; rr < 8; ++rr) {
            const int i = wv * 8 + rr;
            float a0 = qs[i * 129 + lane], a1 = qs[i * 129 + 64 + lane];
            float ss = wsum_l(a0 * a0 + a1 * a1, lane_u); float sc = rsqrtf(ss + 1e-6f) * 0.08838834764831845f;
            qb[i * 136 + lane] = f2bf(a0 * sc); qb[i * 136 + 64 + lane] = f2bf(a1 * sc);
            a0 = ks[i * 129 + lane]; a1 = ks[i * 129 + 64 + lane];
            ss = wsum_l(a0 * a0 + a1 * a1, lane_u); sc = rsqrtf(ss + 1e-6f);
            kb[i * 136 + lane] = f2bf(a0 * sc); kb[i * 136 + 64 + lane] = f2bf(a1 * sc);
        }
        __syncthreads();
        {
            const int l15 = lane & 15, lq = lane >> 4, tr = wv >> 1, tc0 = 2 * (wv & 1);
            bf16x8 aK[4], aQ[4];
#pragma unroll
            for (int ksx = 0; ksx < 4; ++ksx) { aK[ksx] = *(LAS const bf16x8*)(kb + (16 * tr + l15) * 136 + 32 * ksx + 8 * lq); aQ[ksx] = *(LAS const bf16x8*)(qb + (16 * tr + l15) * 136 + 32 * ksx + 8 * lq); }
#pragma unroll
            for (int tcx = 0; tcx < 2; ++tcx) {
                const int tc = tc0 + tcx;
                f32x4 cK = {0.f, 0.f, 0.f, 0.f}, cQ = {0.f, 0.f, 0.f, 0.f};
#pragma unroll
                for (int ksx = 0; ksx < 4; ++ksx) {
                    const bf16x8 b = *(LAS const bf16x8*)(kb + (16 * tc + l15) * 136 + 32 * ksx + 8 * lq);
                    cK = __builtin_amdgcn_mfma_f32_16x16x32_bf16(aK[ksx], b, cK, 0, 0, 0);
                    cQ = __builtin_amdgcn_mfma_f32_16x16x32_bf16(aQ[ksx], b, cQ, 0, 0, 0);
                }
#pragma unroll
                for (int r = 0; r < 4; ++r) { KKs[(16 * tr + 4 * lq + r) * 64 + 16 * tc + l15] = cK[r]; QKs[(16 * tr + 4 * lq + r) * 64 + 16 * tc + l15] = cQ[r]; }
            }
            {
                const int i = tid >> 3, d0 = (tid & 7) * 16;
                bf16_t* dst = Qb + (size_t)(n * 16 + j) * 8192 + i * 128 + d0;
                const u32x4 v0 = *(LAS const u32x4*)(qb + i * 136 + d0), v1 = *(LAS const u32x4*)(qb + i * 136 + d0 + 8);
                if (!dry) { *(u32x4*)dst = v0; *(u32x4*)(dst + 8) = v1; }
            }
            {
                const int d = tid >> 2, i0 = (tid & 3) * 16; unsigned pk[8];
#pragma unroll
                for (int e = 0; e < 8; ++e) pk[e] = (unsigned)kb[(i0 + 2 * e) * 136 + d] | ((unsigned)kb[(i0 + 2 * e + 1) * 136 + d] << 16);
                bf16_t* dst = Kb + (size_t)(n * 16 + j) * 8192 + d * 64 + i0;
                u32x4 v0, v1; v0.x = pk[0]; v0.y = pk[1]; v0.z = pk[2]; v0.w = pk[3]; v1.x = pk[4]; v1.y = pk[5]; v1.z = pk[6]; v1.w = pk[7];
                if (!dry) { *(u32x4*)dst = v0; *(u32x4*)(dst + 8) = v1; }
            }
        }
        int tl_ = tid & 255; asm volatile("" : "+v"(tl_));
        const int hh = tid >> 8, tl = tl_, h = 2 * j + hh;
        if (tl < 64) {
            const int row = n * 64 + tl;
            const float a = AB[(size_t)row * 64 + h], b = AB[(size_t)row * 64 + 32 + h];
            const float x = a + dt_bias[h];
            const float sp = (x > 20.f) ? x : log1pf(expf(x));
            float gc = -expf(a_log[h]) * sp;
#pragma unroll
            for (int off = 1; off < 64; off <<= 1) { const float t = bperm_f((lane_u - off) & 63, gc); if (lane_u >= off) gc += t; }
            gcs[hh * 64 + tl] = gc; bts[hh * 64 + tl] = 1.0f / (1.0f + expf(-b));
            if (!dry) gcb[(size_t)h * T + row] = gc;
        }
        __syncthreads();
        {
            const int i = tl >> 2, jx0 = (tl & 3) * 16;
            const float gi = gcs[hh * 64 + i], bi = bts[hh * 64 + i]; float f[16], am[16];
#pragma unroll
            for (int k = 0; k < 16; ++k) {
                const int jx = jx0 + k;
                const float dec = (jx <= i) ? __expf(gi - gcs[hh * 64 + jx]) : 0.f;
                am[k] = (jx < i) ? bi * KKs[i * 64 + jx] * dec : 0.f;
                f[k] = QKs[i * 64 + jx] * dec;
            }
            *(LAS u32x4*)(Am + hh * 4096 + i * 64 + jx0) = pack8(am); *(LAS u32x4*)(Am + hh * 4096 + i * 64 + jx0 + 8) = pack8(am + 8);
            bf16_t* dst = qkd + ((size_t)(h * 256 + n) * 64 + i) * 64 + jx0;
            if (!dry) { *(u32x4*)dst = pack8(f); *(u32x4*)(dst + 8) = pack8(f + 8); }
        }
        __syncthreads();
        {
            const int c = tl; float X[64];
            LAS const float* bt = bts + hh * 64; LAS const float* gcp = gcs + hh * 64;
            if (c < 128) {
                const bf16_t* src = Vb + (size_t)(n * 32 + h) * 8192 + c;
                const int ch = 4096 + h * 128 + c;
                const float w0 = convw[ch], w1 = convw[8192 + ch], w2 = convw[2 * 8192 + ch], w3 = convw[3 * 8192 + ch];
                float xm3 = 0.f, xm2 = 0.f, xm1 = 0.f;
                if (n > 0) { const bf16_t* hp = HALO + (size_t)(n - 1) * 3 * 8192 + ch; xm3 = bf2f(hp[0]); xm2 = bf2f(hp[8192]); xm1 = bf2f(hp[2 * 8192]); }
#pragma unroll
                for (int i = 0; i < 64; ++i) {
                    const float x0 = bf2f(src[i * 128]);
                    const float y = w0 * xm3 + w1 * xm2 + w2 * xm1 + w3 * x0;
                    X[i] = bt[i] * siluf(y);
                    xm3 = xm2; xm2 = xm1; xm1 = x0;
                }
            } else {
                const int d = c - 128;
#pragma unroll
                for (int i = 0; i < 64; ++i) X[i] = bt[i] * __expf(gcp[i]) * bf2f(kb[i * 136 + d]);
            }
            LAS const bf16_t* Ah = Am + hh * 4096;
#pragma clang loop unroll(full)
            for (int i = 1; i < 64; ++i) {
                float s0 = 0.f, s1 = 0.f, s2 = 0.f, s3 = 0.f;
#pragma clang loop unroll(full)
                for (int j8 = 0; j8 < 8; ++j8) if (j8 * 8 < i) {
                    const u32x4 a8 = *(LAS const u32x4*)(Ah + i * 64 + j8 * 8);
                    if (j8 * 8 + 0 < i) s0 += bflo(a8.x) * X[j8 * 8 + 0];
                    if (j8 * 8 + 1 < i) s1 += bfhi(a8.x) * X[j8 * 8 + 1];
                    if (j8 * 8 + 2 < i) s2 += bflo(a8.y) * X[j8 * 8 + 2];
                    if (j8 * 8 + 3 < i) s3 += bfhi(a8.y) * X[j8 * 8 + 3];
                    if (j8 * 8 + 4 < i) s0 += bflo(a8.z) * X[j8 * 8 + 4];
                    if (j8 * 8 + 5 < i) s1 += bfhi(a8.z) * X[j8 * 8 + 5];
                    if (j8 * 8 + 6 < i) s2 += bflo(a8.w) * X[j8 * 8 + 6];
                    if (j8 * 8 + 7 < i) s3 += bfhi(a8.w) * X[j8 * 8 + 7];
                }
                X[i] -= (s0 + s1) + (s2 + s3);
            }
            if (c < 128) {
                bf16_t* dst = Vb + (size_t)(n * 32 + h) * 8192 + c;
#pragma unroll
                for (int i = 0; i < 64; ++i) if (!dry) dst[i * 128] = f2bf(X[i]);
            } else {
                bf16_t* dst = gdn_wptr(ws, h) + (size_t)(n * 64) * 128 + (c - 128);
#pragma unroll
                for (int i = 0; i < 64; ++i) if (!dry) dst[i * 128] = f2bf(X[i]);
            }
        }
        __syncthreads();
    }
}

__device__ __forceinline__ void gdn_g2(unsigned char* ws, LAS unsigned char* lds, int kwid, const bool dry = false) {
    constexpr int BUFSZ = 62464, OFF_W = 0, OFF_Q = 17408, OFF_K = 34816, OFF_QK = 53248, OFF_ST = 2 * BUFSZ, OFF_VN = OFF_ST + 4352, OFF_VS = OFF_VN + 2304;
    const bf16_t* Qb = (const bf16_t*)(ws + 113 * MiB); const bf16_t* Kb = (const bf16_t*)(ws + 177 * MiB); bf16_t* Vb = (bf16_t*)(ws + 241 * MiB);
    const bf16_t* qkd = (const bf16_t*)(ws + 49 * MiB); const float* gcb = (const float*)(ws + 601 * MiB);
    const int tid = tid_op(kwid), lane = tid & 63, w = tid >> 6, l15 = lane & 15, lq = lane >> 4, mt = w & 3;
    for (int u0 = blockIdx.x; u0 < 256; u0 += gridDim.x) {
        const int unit = (gridDim.x == 256) ? ((u0 & 7) * 32 + (u0 >> 3)) : u0;
        const int h = unit >> 3, s = unit & 7, j = h >> 1;
        const bf16_t* wh = gdn_wptr(ws, h);
        const float* gch = gcb + (size_t)h * T;
        f32x4 Sacc = {0.f, 0.f, 0.f, 0.f};
        for (int i = tid; i < (4352 + 2304 + 2304) / 4; i += 512) ((LAS unsigned*)(lds + OFF_ST))[i] = 0u;
        u32x4 RA[7], RB[7]; unsigned short unA[4], unB[4]; f32x4 gcnA, gcnB; float glnA, glnB;
#define G2_LOAD(X, nn) do { \
            _Pragma("unroll") for (int k = 0; k < 7; ++k) { const int pid = tid + 512 * k; const bf16_t* src; \
                if (k < 2) src = wh + (size_t)(nn) * 8192 + (size_t)pid * 8; \
                else if (k < 4) src = Qb + (size_t)((nn) * 16 + j) * 8192 + (size_t)(pid - 1024) * 8; \
                else if (k < 6) src = Kb + (size_t)((nn) * 16 + j) * 8192 + (size_t)(pid - 2048) * 8; \
                else src = qkd + (size_t)(h * 256 + (nn)) * 4096 + (size_t)(pid - 3072) * 8; \
                R##X[k] = *(const u32x4*)src; } \
            { const bf16_t* up = Vb + (size_t)((nn) * 32 + h) * 8192 + (size_t)(16 * mt + 4 * lq) * 128 + s * 16 + l15; \
              un##X[0] = up[0]; un##X[1] = up[128]; un##X[2] = up[256]; un##X[3] = up[384]; } \
            gcn##X = *(const f32x4*)(gch + (nn) * 64 + 16 * mt + 4 * lq); gln##X = gch[(nn) * 64 + 63]; } while (0)
#define G2_STORE(X, bufoff) do { \
            _Pragma("unroll") for (int k = 0; k < 7; ++k) { const int pid = tid + 512 * k; int off; \
                if (k < 2) off = OFF_W + ((pid >> 4) * 136 + (pid & 15) * 8) * 2; \
                else if (k < 4) off = OFF_Q + (((pid - 1024) >> 4) * 136 + ((pid - 1024) & 15) * 8) * 2; \
                else if (k < 6) off = OFF_K + (((pid - 2048) >> 3) * 72 + ((pid - 2048) & 7) * 8) * 2; \
                else off = OFF_QK + (((pid - 3072) >> 3) * 72 + ((pid - 3072) & 7) * 8) * 2; \
                *(LAS u32x4*)(lds + (bufoff) + off) = R##X[k]; } \
            _Pragma("unroll") for (int r = 0; r < 4; ++r) uc[r] = bf2f(un##X[r]); \
            gcc = gcn##X; glc = gln##X; } while (0)
        float uc[4]; f32x4 gcc; float glc;
        G2_LOAD(A, 0);
        G2_STORE(A, 0);
        G2_LOAD(B, 1);
        __syncthreads();
#define G2_STEP(n, XL, XS) do { \
            const int bo = ((n) & 1) * BUFSZ; \
            G2_LOAD(XL, ((n) + 2 < 256 ? (n) + 2 : 255));     \
            f32x4 acc = {0.f, 0.f, 0.f, 0.f}; \
            { LAS const unsigned char* Ab = lds + bo + (w < 4 ? OFF_W : OFF_Q) + ((16 * mt + l15) * 136 + 8 * lq) * 2; \
              LAS const unsigned char* Bb = lds + OFF_ST + (l15 * 136 + 8 * lq) * 2; \
              _Pragma("unroll") for (int ksx = 0; ksx < 4; ++ksx) { \
                  const bf16x8 a = *(LAS const bf16x8*)(Ab + ksx * 64), b = *(LAS const bf16x8*)(Bb + ksx * 64); \
                  acc = __builtin_amdgcn_mfma_f32_16x16x32_bf16(a, b, acc, 0, 0, 0); } } \
            if (w < 4) { \
                float vn[4], vs[4]; \
                _Pragma("unroll") for (int r = 0; r < 4; ++r) { vn[r] = uc[r] - acc[r]; vs[r] = vn[r] * __expf(glc - gcc[r]); } \
                u32x2 a; a[0] = pack2(vn[0], vn[1]); a[1] = pack2(vn[2], vn[3]); \
                u32x2 b; b[0] = pack2(vs[0], vs[1]); b[1] = pack2(vs[2], vs[3]); \
                *(LAS u32x2*)(lds + OFF_VN + (l15 * 72 + 16 * mt + 4 * lq) * 2) = a; \
                *(LAS u32x2*)(lds + OFF_VS + (l15 * 72 + 16 * mt + 4 * lq) * 2) = b; } \
            __syncthreads(); \
            if (w >= 4) { \
                f32x4 o; \
                _Pragma("unroll") for (int r = 0; r < 4; ++r) o[r] = __expf(gcc[r]) * acc[r]; \
                LAS const unsigned char* Ab = lds + bo + OFF_QK + ((16 * mt + l15) * 72 + 8 * lq) * 2; \
                LAS const unsigned char* Bb = lds + OFF_VN + (l15 * 72 + 8 * lq) * 2; \
                _Pragma("unroll") for (int ksx = 0; ksx < 2; ++ksx) { \
                    const bf16x8 a = *(LAS const bf16x8*)(Ab + ksx * 64), b = *(LAS const bf16x8*)(Bb + ksx * 64); \
                    o = __builtin_amdgcn_mfma_f32_16x16x32_bf16(a, b, o, 0, 0, 0); } \
                bf16_t* op = Vb + (size_t)((n) * 32 + h) * 8192 + (size_t)(16 * mt + 4 * lq) * 128 + s * 16 + l15; \
                if (!dry) { op[0] = f2bf(o[0]); op[128] = f2bf(o[1]); op[256] = f2bf(o[2]); op[384] = f2bf(o[3]); } } \
            { const float gf = __expf(glc); \
              _Pragma("unroll") for (int r = 0; r < 4; ++r) Sacc[r] *= gf; \
              LAS const unsigned char* Ab = lds + bo + OFF_K + ((16 * w + l15) * 72 + 8 * lq) * 2; \
              LAS const unsigned char* Bb = lds + OFF_VS + (l15 * 72 + 8 * lq) * 2; \
              _Pragma("unroll") for (int ksx = 0; ksx < 2; ++ksx) { \
                  const bf16x8 a = *(LAS const bf16x8*)(Ab + ksx * 64), b = *(LAS const bf16x8*)(Bb + ksx * 64); \
                  Sacc = __builtin_amdgcn_mfma_f32_16x16x32_bf16(a, b, Sacc, 0, 0, 0); } \
              u32x2 sv; sv[0] = pack2(Sacc[0], Sacc[1]); sv[1] = pack2(Sacc[2], Sacc[3]); \
              *(LAS u32x2*)(lds + OFF_ST + (l15 * 136 + 16 * w + 4 * lq) * 2) = sv; } \
            if ((n) + 1 < 256) G2_STORE(XS, (((n) + 1) & 1) * BUFSZ); \
            __syncthreads(); } while (0)
        for (int n = 0; n < 256; n += 2) { G2_STEP(n, A, B); G2_STEP(n + 1, B, A); }
#undef G2_STEP
#undef G2_LOAD
#undef G2_STORE
    }
}

__device__ __forceinline__ void gdn_g3(const float* __restrict__ norm_g, const bf16_t* Ob, bf16_t* Z, int kwid) {
    const int tidx = tid_op(kwid), lane = tidx & 63, sub = lane & 15, gw = blockIdx.x * 8 + (tidx >> 6), nw = gridDim.x * 8;
    float ng[8];
#pragma unroll
    for (int k = 0; k < 8; ++k) ng[k] = norm_g[sub * 8 + k];
    for (int pi = gw * 4 + (lane >> 4); pi < T * 32; pi += nw * 8) {
        u32x4 oq[2], zq[2]; bf16_t* zp[2];
#pragma unroll
        for (int q = 0; q < 2; ++q) {
            const int pj = pi + q * nw * 4, t = pj >> 5, h = pj & 31;
            oq[q] = *(const u32x4*)(Ob + ((size_t)((t >> 6) * 32 + h) * 64 + (t & 63)) * 128 + sub * 8);
            zp[q] = Z + (size_t)t * 4096 + h * 128 + sub * 8;
            zq[q] = *(const u32x4*)zp[q];
        }
#pragma unroll
        for (int q = 0; q < 2; ++q) {
            float o[8], z[8], r[8];
            unpack8(oq[q], o); unpack8(zq[q], z);
            float ss = 0.f;
#pragma unroll
            for (int k = 0; k < 8; ++k) ss += o[k] * o[k];
            ss += __shfl_xor(ss, 1); ss += __shfl_xor(ss, 2); ss += __shfl_xor(ss, 4); ss += __shfl_xor(ss, 8);
            const float rs = rsqrtf(ss * (1.0f / 128.0f) + 1e-6f);
#pragma unroll
            for (int k = 0; k < 8; ++k) r[k] = o[k] * rs * ng[k] * siluf(z[k]);
            *(u32x4*)zp[q] = pack8(r);
        }
    }
}
__device__ __forceinline__ void dsa_kiln(const float* ki, const float* __restrict__ g, const float* __restrict__ b, bf16_t* out, int kwid) {
    const int tidx = tid_op(kwid), lane = tidx & 63, gw = blockIdx.x * 8 + (tidx >> 6), nw = gridDim.x * 8;
    const float g0 = g[lane * 2], g1 = g[lane * 2 + 1], b0 = b[lane * 2], b1 = b[lane * 2 + 1];
    for (int row = gw; row < T; row += nw) {
        const float2 v = *(const float2*)(ki + (size_t)row * 128 + lane * 2);
        const float mean = wave_sum(v.x + v.y) * (1.0f / 128.0f);
        const float d0 = v.x - mean, d1 = v.y - mean;
        const float var = wave_sum(d0 * d0 + d1 * d1) * (1.0f / 128.0f);
        const float rstd = rsqrtf(var + 1e-5f);
        *(unsigned*)(out + (size_t)row * 128 + lane * 2) = pack2(d0 * rstd * g0 + b0, d1 * rstd * g1 + b1);
    }
}
__device__ __forceinline__ float relu_i(float x) { const int b = __float_as_int(x); return __int_as_float(b > 0 ? b : 0); }
__device__ __forceinline__ unsigned ord_key(float f) { const unsigned u = __float_as_uint(f); return (u & 0x80000000u) ? ~u : (u | 0x80000000u); }
__device__ __forceinline__ int rel_bucket(int d) {
    if (d < 16) return d;
    const float v = logf((float)d * 0.0625f) * 7.694248476257048f;
    const int l = 16 + (int)v; return l < 31 ? l : 31;
}
template <bool PACKED> __device__ __forceinline__ int radix_pick_t(LAS unsigned* hist, int nb, int lane, int& kth, int& cbin) {
    const int per = nb >> 6, base = lane * per;
    int tot = 0;
    for (int b = 0; b < per; ++b) { const int bb = base + b; tot += PACKED ? (int)((hist[bb >> 1] >> (16 * (bb & 1))) & 0xffffu) : (int)hist[bb]; }
    int v = tot;
#pragma unroll
    for (int off = 1; off < 64; off <<= 1) { const int t = bperm_i((lane + off) & 63, v); if (lane + off < 64) v += t; }
    const int excl = v - tot;
    const bool mine = (excl < kth) && (v >= kth);
    int dsel = 0, ksel = 0, csel = 0, c = excl; bool found = false;
    for (int b = per - 1; b >= 0; --b) { const int bb = base + b; const int hv = PACKED ? (int)((hist[bb >> 1] >> (16 * (bb & 1))) & 0xffffu) : (int)hist[bb];
        if (mine && !found && c + hv >= kth) { dsel = bb; ksel = kth - c; csel = hv; found = true; } c += hv; }
    const unsigned long long m = __ballot(mine);
    const int src = __builtin_amdgcn_readfirstlane((m == 0ull) ? 0 : (__ffsll((long long)m) - 1));
    dsel = __builtin_amdgcn_readlane(dsel, src); ksel = __builtin_amdgcn_readlane(ksel, src); cbin = __builtin_amdgcn_readlane(csel, src);
    kth = ksel; return dsel;
}
__device__ __forceinline__ int radix_pick(LAS unsigned* hist, int nb, int lane, int& kth) { int c; return radix_pick_t<false>(hist, nb, lane, kth, c); }

__device__ __forceinline__ void dsa_phase(const bf16_t* qi, const bf16_t* kib, const float* wi, bf16_t* q1, const bf16_t* k1, const bf16_t* v1,
                                          float* scratch, const float* __restrict__ rel_bias, LAS unsigned char* lds, int kwid) {
    LAS bf16_t* kit = (LAS bf16_t*)(lds + 65536);
    LAS int* sel = (LAS int*)(lds + 135168);
    float* sc = scratch + (size_t)blockIdx.x * 16 * T;
    for (int kk = blockIdx.x; kk < 512; kk += gridDim.x)
#pragma unroll 1
        for (int half = 0; half < 2; ++half) {
            const int tid = tid_op(kwid), lane = tid & 63, w = __builtin_amdgcn_readfirstlane(tid >> 6), lh = lane >> 5, l31 = lane & 31;
            LAS unsigned* hist = (LAS unsigned*)lds + w * 2048;
            LAS float* qf = (LAS float*)lds + w * 2048;
            LAS bf16_t* pl = (LAS bf16_t*)(lds + 65536) + w * 4096;
            const int unit = half ? 1023 - kk : kk, t0 = unit * 16;
            if (t0 >= 256) {
                const int qg = w & 3, kh = w >> 2;
                bf16x8 af[2][8]; float wv[2][16];
#pragma unroll
                for (int mi = 0; mi < 2; ++mi) {
                    const int tq = t0 + 4 * qg + 2 * mi + (l31 >> 4), hd = l31 & 15;
                    const bf16_t* ap = qi + (size_t)tq * 2048 + hd * 128 + 8 * lh;
#pragma unroll
                    for (int ksx = 0; ksx < 8; ++ksx) af[mi][ksx] = *(const bf16x8*)(ap + ksx * 16);
#pragma unroll
                    for (int r = 0; r < 16; ++r) wv[mi][r] = wi[(size_t)(t0 + 4 * qg + 2 * mi + (r >> 3)) * 16 + (r & 3) + 8 * ((r >> 2) & 1) + 4 * lh];
                }
                const int ntile = (t0 + 16 + 127) >> 7;
                u32x4 pre[4];
#pragma unroll
                for (int i = 0; i < 4; ++i) pre[i] = *(const u32x4*)(kib + (size_t)(tid + 512 * i) * 8);
                __syncthreads();
                {
                    u32x4 z; z.x = z.y = z.z = z.w = 0u;
#pragma unroll
                    for (int i = 0; i < 8; ++i) *(LAS u32x4*)(lds + (size_t)(tid + 512 * i) * 16) = z;
                }
#pragma unroll
                for (int i = 0; i < 4; ++i) { const int pid = tid + 512 * i, row = pid >> 4, c8 = pid & 15; *(LAS u32x4*)(kit + row * 136 + c8 * 8) = pre[i]; }
                __syncthreads();
                for (int kt = 0; kt < ntile; ++kt) {
                    LAS const bf16_t* kcur = kit + (kt & 1) * (128 * 136);
                    {
                        const int ktn = (kt + 1 < ntile) ? kt + 1 : kt;
#pragma unroll
                        for (int i = 0; i < 4; ++i) pre[i] = *(const u32x4*)(kib + (size_t)ktn * 16384 + (size_t)(tid + 512 * i) * 8);
                    }
#pragma unroll
                    for (int nbx = 0; nbx < 2; ++nbx) {
                        const int nb = 2 * kh + nbx;
                        LAS const bf16_t* bp = kcur + (nb * 32 + l31) * 136 + 8 * lh;
                        const int key = kt * 128 + nb * 32 + l31;
                        f32x16 acc0, acc1;
#pragma unroll
                        for (int r = 0; r < 16; ++r) { acc0[r] = 0.f; acc1[r] = 0.f; }
#pragma unroll
                        for (int ksx = 0; ksx < 8; ++ksx) {
                            const bf16x8 b = *(LAS const bf16x8*)(bp + ksx * 16);
                            acc0 = __builtin_amdgcn_mfma_f32_32x32x16_bf16(af[0][ksx], b, acc0, 0, 0, 0);
                            acc1 = __builtin_amdgcn_mfma_f32_32x32x16_bf16(af[1][ksx], b, acc1, 0, 0, 0);
                        }
#pragma unroll
                        for (int mi = 0; mi < 2; ++mi) {
                            float s0 = 0.f, s1 = 0.f;
#pragma unroll
                            for (int r = 0; r < 8; ++r) { const float x0 = mi ? acc1[r] : acc0[r], x1 = mi ? acc1[8 + r] : acc0[8 + r]; s0 += wv[mi][r] * relu_i(x0); s1 += wv[mi][8 + r] * relu_i(x1); }
                            const float snd = lh ? s0 : s1, rcv = bperm_f(lane ^ 32, snd), tot = (lh ? s1 : s0) + rcv;
                            const int ql = 4 * qg + 2 * mi + lh;
                            if (key <= t0 + ql) { sc[(size_t)ql * T + key] = tot;
                                const unsigned bin = ord_key(tot) >> 21;
                                __hip_atomic_fetch_add((LAS unsigned*)(lds + ql * 4096) + (bin >> 1), 1u << (16 * (bin & 1u)), __ATOMIC_RELAXED, __HIP_MEMORY_SCOPE_WORKGROUP); }
                        }
                    }
                    if (kt + 1 < ntile) {
                        LAS bf16_t* knext = kit + ((kt + 1) & 1) * (128 * 136);
#pragma unroll
                        for (int i = 0; i < 4; ++i) { const int pid = tid + 512 * i, row = pid >> 4, c8 = pid & 15; *(LAS u32x4*)(knext + row * 136 + c8 * 8) = pre[i]; }
                    }
                    __syncthreads();
                }
            }
            asm volatile("s_waitcnt vmcnt(0)" ::: "memory");
            __builtin_amdgcn_fence(__ATOMIC_ACQUIRE, "agent");
            __syncthreads();
            int d0q[2] = {0, 0}, kthq[2] = {256, 256}, c0q[2] = {0, 0};
            if (t0 >= 256) {
                const int lane0 = tid_op(kwid) & 63;
#pragma unroll
                for (int qx = 0; qx < 2; ++qx) { int kk_ = 256, cc_ = 0; d0q[qx] = radix_pick_t<true>((LAS unsigned*)(lds + (2 * w + qx) * 4096), 2048, lane0, kk_, cc_); kthq[qx] = kk_; c0q[qx] = cc_; }
                wave_sync();
            }
#pragma unroll 1
            for (int qq = 0; qq < 2; ++qq) {
                int lane_q = tid_op(kwid) & 63;
                const int lane = lane_q;
                const int ql = 2 * w + qq, t = t0 + ql, nk = t + 1;
                LAS int* selq = sel + ql * 256;
                int nsel;
                if (nk <= 256) { for (int s = lane; s < nk; s += 64) selq[s] = s; nsel = nk; }
#ifndef DSA_REP_B
#define DSA_REP_B 1
#endif
                else for (int repb = 0; repb < DSA_REP_B; ++repb) {
                    const float* srow = sc + (size_t)ql * T;
                    int kth = qq ? kthq[1] : kthq[0]; unsigned d0 = (unsigned)(qq ? d0q[1] : d0q[0]), d1, d2;
                    const int c0 = qq ? c0q[1] : c0q[0];
                    if (c0 <= 1024) {
                        LAS unsigned* cu = (LAS unsigned*)(lds + 65536) + w * 2048; LAS unsigned* ck = cu + 1024;
                        const unsigned long long ltmask = (lane == 0) ? 0ull : (~0ull >> (64 - lane));
                        int cnt = 0, ccnt = 0;
                        for (int kb = 0; kb < nk; kb += 512) { float fv[8];
#pragma unroll
                            for (int jx = 0; jx < 8; ++jx) { const int key = kb + 64 * jx + lane; fv[jx] = srow[key < nk ? key : nk - 1]; }
#pragma unroll
                            for (int jx = 0; jx < 8; ++jx) {
                                const int key = kb + 64 * jx + lane; const bool in = key < nk;
                                const unsigned u = in ? ord_key(fv[jx]) : 0u; const unsigned bin = u >> 21;
                                const bool gt = in && (bin > d0), eq = in && (bin == d0);
                                const unsigned long long mg = __ballot(gt), me = __ballot(eq);
                                const int pg = cnt + __popcll(mg & ltmask), pe = ccnt + __popcll(me & ltmask);
                                if (gt && pg < 256) selq[pg] = key;
                                if (eq && pe < 1024) { cu[pe] = u; ck[pe] = (unsigned)key; }
                                cnt += __popcll(mg); ccnt += __popcll(me);
                            }
                        }
                        for (int b = lane; b < 2048; b += 64) hist[b] = 0u;
                        wave_sync();
                        for (int i = lane; i < c0; i += 64) __hip_atomic_fetch_add(&hist[(cu[i] >> 10) & 2047u], 1u, __ATOMIC_RELAXED, __HIP_MEMORY_SCOPE_WORKGROUP);
                        wave_sync();
                        d1 = (unsigned)radix_pick(hist, 2048, lane, kth);
                        wave_sync();
                        for (int b = lane; b < 1024; b += 64) hist[b] = 0u;
                        wave_sync();
                        for (int i = lane; i < c0; i += 64) { const unsigned u = cu[i]; if (((u >> 10) & 2047u) == d1) __hip_atomic_fetch_add(&hist[u & 1023u], 1u, __ATOMIC_RELAXED, __HIP_MEMORY_SCOPE_WORKGROUP); }
                        wave_sync();
                        d2 = (unsigned)radix_pick(hist, 1024, lane, kth);
                        wave_sync();
                        const unsigned tau = (d0 << 21) | (d1 << 10) | d2;
                        int eqleft = kth;
                        for (int ib = 0; ib < c0; ib += 64) {
                            const int i = ib + lane; const bool in = i < c0;
                            const unsigned u = in ? cu[i] : 0u;
                            const bool gt = in && (u > tau), eq = in && (u == tau);
                            const unsigned long long meq = __ballot(eq);
                            const bool take = gt || (eq && (__popcll(meq & ltmask) < eqleft));
                            const unsigned long long mt = __ballot(take);
                            const int pos = cnt + __popcll(mt & ltmask);
                            if (take && pos < 256) selq[pos] = (int)ck[i];
                            cnt += __popcll(mt);
                            const int neq = __popcll(meq); eqleft -= (neq < eqleft ? neq : eqleft);
                        }
                    } else {
                    for (int b = lane; b < 2048; b += 64) hist[b] = 0u;
                    wave_sync();
                    for (int key0 = lane; key0 < nk; key0 += 512) { float fv[8];
#pragma unroll
                        for (int jx = 0; jx < 8; ++jx) { const int key = key0 + 64 * jx; fv[jx] = srow[key < nk ? key : nk - 1]; }
#pragma unroll
                        for (int jx = 0; jx < 8; ++jx) { const int key = key0 + 64 * jx; if (key < nk) { const unsigned u = ord_key(fv[jx]); if ((u >> 21) == d0) __hip_atomic_fetch_add(&hist[(u >> 10) & 2047u], 1u, __ATOMIC_RELAXED, __HIP_MEMORY_SCOPE_WORKGROUP); } } }
                    wave_sync();
                    d1 = (unsigned)radix_pick(hist, 2048, lane, kth);
                    wave_sync();
                    for (int b = lane; b < 1024; b += 64) hist[b] = 0u;
                    wave_sync();
                    const unsigned pre = (d0 << 11) | d1;
                    for (int key0 = lane; key0 < nk; key0 += 512) { float fv[8];
#pragma unroll
                        for (int jx = 0; jx < 8; ++jx) { const int key = key0 + 64 * jx; fv[jx] = srow[key < nk ? key : nk - 1]; }
#pragma unroll
                        for (int jx = 0; jx < 8; ++jx) { const int key = key0 + 64 * jx; if (key < nk) { const unsigned u = ord_key(fv[jx]); if ((u >> 10) == pre) __hip_atomic_fetch_add(&hist[u & 1023u], 1u, __ATOMIC_RELAXED, __HIP_MEMORY_SCOPE_WORKGROUP); } } }
                    wave_sync();
                    d2 = (unsigned)radix_pick(hist, 1024, lane, kth);
                    wave_sync();
                    const unsigned tau = (pre << 10) | d2;
                    int cnt = 0, eqleft = kth;
                    const unsigned long long ltmask = (lane == 0) ? 0ull : (~0ull >> (64 - lane));
                    for (int kb = 0; kb < nk; kb += 512) { float fv[8];
#pragma unroll
                        for (int jx = 0; jx < 8; ++jx) { const int key = kb + 64 * jx + lane; fv[jx] = srow[key < nk ? key : nk - 1]; }
#pragma unroll
                        for (int jx = 0; jx < 8; ++jx) {
                            const int key = kb + 64 * jx + lane; const bool in = key < nk;
                            const unsigned u = in ? ord_key(fv[jx]) : 0u;
                            const bool gt = in && (u > tau), eq = in && (u == tau);
                            const unsigned long long meq = __ballot(eq);
                            const bool take = gt || (eq && (__popcll(meq & ltmask) < eqleft));
                            const unsigned long long mt = __ballot(take);
                            const int pos = cnt + __popcll(mt & ltmask);
                            if (take && pos < 256) selq[pos] = key;
                            cnt += __popcll(mt);
                            const int neq = __popcll(meq); eqleft -= (neq < eqleft ? neq : eqleft);
                        }
                    }
                    }
                    nsel = 256;
                }
                wave_sync();
#ifndef DSA_REP_C
#define DSA_REP_C 1
#endif
                for (int repc = 0; repc < DSA_REP_C; ++repc) {
                LAS float* invs = (LAS float*)(lds + 151552) + w * 16;
                {
                    int lane_g = lane_q; asm volatile("" : "+v"(lane_g)); const int lane = lane_g;
                    const int l15 = lane & 15, lq = lane >> 4;
                    bf16x8 af[4];
#pragma unroll
                    for (int ksx = 0; ksx < 4; ++ksx) af[ksx] = *(const bf16x8*)(q1 + (size_t)t * 2048 + l15 * 128 + 32 * ksx + 8 * lq);
                    float mx[4] = {-INFINITY, -INFINITY, -INFINITY, -INFINITY};
                    const int ntile = (nsel + 15) >> 4;
                    bf16x8 bA[4][4], bB[4][4]; int idxA = 0, idxB = 0;
#define ATT_LOAD(X, tl) do { const int s_ = (tl) * 16 + l15; idx##X = (s_ < nsel) ? selq[s_] : 0; \
                        const bf16_t* kr_ = k1 + (size_t)idx##X * 512 + 8 * lq; \
                        _Pragma("unroll") for (int g_ = 0; g_ < 4; ++g_) _Pragma("unroll") for (int k_ = 0; k_ < 4; ++k_) b##X[g_][k_] = *(const bf16x8*)(kr_ + g_ * 128 + 32 * k_); } while (0)
#define ATT_TILE(X, tl) do { const int s_ = (tl) * 16 + l15; const bool valid_ = s_ < nsel; \
                        f32x4 sel_ = {0.f, 0.f, 0.f, 0.f}; \
                        _Pragma("unroll") for (int g_ = 0; g_ < 4; ++g_) { f32x4 acc_ = {0.f, 0.f, 0.f, 0.f}; \
                            _Pragma("unroll") for (int k_ = 0; k_ < 4; ++k_) acc_ = __builtin_amdgcn_mfma_f32_16x16x32_bf16(af[k_], b##X[g_][k_], acc_, 0, 0, 0); \
                            if (lq == g_) sel_ = acc_; } \
                        const int bk_ = rel_bucket(t - idx##X); const f32x4 rb_ = *(const f32x4*)(rel_bias + bk_ * 16 + 4 * lq); \
                        float l_[4]; \
                        _Pragma("unroll") for (int r_ = 0; r_ < 4; ++r_) { l_[r_] = valid_ ? sel_[r_] * 0.08838834764831845f + rb_[r_] : -INFINITY; mx[r_] = fmaxf(mx[r_], l_[r_]); } \
                        u32x2 pk_; pk_[0] = pack2(l_[0], l_[1]); pk_[1] = pack2(l_[2], l_[3]); \
                        *(LAS u32x2*)(pl + s_ * 16 + 4 * lq) = pk_; } while (0)
                    ATT_LOAD(A, 0);
                    for (int tl = 0; tl < ntile; tl += 2) {
                        ATT_LOAD(B, tl + 1);
                        ATT_TILE(A, tl);
                        ATT_LOAD(A, tl + 2);
                        if (tl + 1 < ntile) ATT_TILE(B, tl + 1);
                    }
#undef ATT_LOAD
#undef ATT_TILE
#pragma unroll
                    for (int r = 0; r < 4; ++r) { float m = mx[r]; m = fmaxf(m, bperm_f(lane ^ 8, m)); m = fmaxf(m, bperm_f(lane ^ 4, m)); m = fmaxf(m, bperm_f(lane ^ 2, m)); m = fmaxf(m, bperm_f(lane ^ 1, m)); mx[r] = m; }
                    float sm[4] = {0.f, 0.f, 0.f, 0.f};
#pragma unroll 1
                    for (int tl = 0; tl < ntile; ++tl) {
                        const int s = tl * 16 + l15;
                        const u32x2 pk = *(LAS const u32x2*)(pl + s * 16 + 4 * lq);
                        const float e0 = __expf(bflo(pk[0]) - mx[0]), e1 = __expf(bfhi(pk[0]) - mx[1]), e2 = __expf(bflo(pk[1]) - mx[2]), e3 = __expf(bfhi(pk[1]) - mx[3]);
                        sm[0] += e0; sm[1] += e1; sm[2] += e2; sm[3] += e3;
                        u32x2 po; po[0] = pack2(e0, e1); po[1] = pack2(e2, e3);
                        *(LAS u32x2*)(pl + s * 16 + 4 * lq) = po;
                    }
#pragma unroll
                    for (int r = 0; r < 4; ++r) { float v = sm[r]; v += bperm_f(lane ^ 8, v); v += bperm_f(lane ^ 4, v); v += bperm_f(lane ^ 2, v); v += bperm_f(lane ^ 1, v); if (l15 == 0) invs[4 * lq + r] = 1.0f / v; }
                }
                wave_sync();
                {
                    int lane_p = lane_q; asm volatile("" : "+v"(lane_p)); const int lane = lane_p;
                    const int gl = lane >> 4;
                    float o[4][8];
#pragma unroll
                    for (int hl = 0; hl < 4; ++hl)
#pragma unroll
                        for (int e = 0; e < 8; ++e) o[hl][e] = 0.f;
                    const bf16_t* vb = v1 + lane * 8;
                    int s = 0;
                    for (; s + 12 <= nsel; s += 12) {
                        u32x4 vv[12];
#pragma unroll
                        for (int jx = 0; jx < 12; ++jx) vv[jx] = *(const u32x4*)(vb + (size_t)selq[s + jx] * 512);
#pragma unroll
                        for (int jx = 0; jx < 12; ++jx) {
                            const u32x2 pk = *(LAS const u32x2*)(pl + (s + jx) * 16 + 4 * gl);
                            const float p0 = bflo(pk[0]), p1 = bfhi(pk[0]), p2 = bflo(pk[1]), p3 = bfhi(pk[1]);
                            float vf[8]; unpack8(vv[jx], vf);
#pragma unroll
                            for (int e = 0; e < 8; ++e) { o[0][e] += p0 * vf[e]; o[1][e] += p1 * vf[e]; o[2][e] += p2 * vf[e]; o[3][e] += p3 * vf[e]; }
                        }
                    }
                    for (; s + 8 <= nsel; s += 8) {
                        u32x4 vv[8];
#pragma unroll
                        for (int jx = 0; jx < 8; ++jx) vv[jx] = *(const u32x4*)(vb + (size_t)selq[s + jx] * 512);
#pragma unroll
                        for (int jx = 0; jx < 8; ++jx) {
                            const u32x2 pk = *(LAS const u32x2*)(pl + (s + jx) * 16 + 4 * gl);
                            const float p0 = bflo(pk[0]), p1 = bfhi(pk[0]), p2 = bflo(pk[1]), p3 = bfhi(pk[1]);
                            float vf[8]; unpack8(vv[jx], vf);
#pragma unroll
                            for (int e = 0; e < 8; ++e) { o[0][e] += p0 * vf[e]; o[1][e] += p1 * vf[e]; o[2][e] += p2 * vf[e]; o[3][e] += p3 * vf[e]; }
                        }
                    }
                    for (; s < nsel; ++s) {
                        const u32x4 vv = *(const u32x4*)(vb + (size_t)selq[s] * 512);
                        const u32x2 pk = *(LAS const u32x2*)(pl + s * 16 + 4 * gl);
                        const float p0 = bflo(pk[0]), p1 = bfhi(pk[0]), p2 = bflo(pk[1]), p3 = bfhi(pk[1]);
                        float vf[8]; unpack8(vv, vf);
#pragma unroll
                        for (int e = 0; e < 8; ++e) { o[0][e] += p0 * vf[e]; o[1][e] += p1 * vf[e]; o[2][e] += p2 * vf[e]; o[3][e] += p3 * vf[e]; }
                    }
#pragma unroll
                    for (int hl = 0; hl < 4; ++hl) { const float inv = invs[4 * gl + hl];
#pragma unroll
                        for (int e = 0; e < 8; ++e) o[hl][e] *= inv;
                        if (repc == DSA_REP_C - 1) *(u32x4*)(q1 + (size_t)t * 2048 + (4 * gl + hl) * 128 + (lane & 15) * 8) = pack8(o[hl]); }
                }
                wave_sync();
                }
            }
            __syncthreads();
        }
}
#ifndef MIXER_STAGE
#define MIXER_STAGE 2
#endif
__device__ __forceinline__ void zero_fill(bf16_t* p, size_t n8, int kwid) {
    u32x4 z; z.x = z.y = z.z = z.w = 0u;
    for (size_t i = (size_t)blockIdx.x * 512 + tid_op(kwid); i < n8; i += (size_t)gridDim.x * 512) ((u32x4*)p)[i] = z;
}

#define WSB(m) ((bf16_t*)(ws + (size_t)(m) * MiB))
#define WSF(m) ((float*)(ws + (size_t)(m) * MiB))
__device__ __forceinline__ void gbar(unsigned* ctr, unsigned& target, int kwid) {
    asm volatile("s_waitcnt vmcnt(0) lgkmcnt(0)" ::: "memory");
    __syncthreads();
    target += gridDim.x;
    if (tid_op(kwid) == 0) {
        __builtin_amdgcn_fence(__ATOMIC_RELEASE, "agent");
        asm volatile("s_waitcnt vmcnt(0)" ::: "memory");
        __hip_atomic_fetch_add(ctr, 1u, __ATOMIC_RELAXED, __HIP_MEMORY_SCOPE_AGENT);
        while (__hip_atomic_load(ctr, __ATOMIC_RELAXED, __HIP_MEMORY_SCOPE_AGENT) < target) __builtin_amdgcn_s_sleep(1);
        __builtin_amdgcn_fence(__ATOMIC_ACQUIRE, "agent");
        asm volatile("s_waitcnt vmcnt(0)" ::: "memory");
    }
    __syncthreads();
}
#define GSYNC() gbar(bctr, btarget, kwid)
template <int L> __device__ __forceinline__ void layer_body(const KP& p, unsigned char* ws, LAS unsigned char* lds, unsigned* bctr, unsigned& btarget, int& tb, const int kwid) {
        constexpr int oA_o = L ? 49 : 369, Ko = L ? 2048 : 4096, oWo = L ? 21 : 113, oY1 = 241, oX1 = L ? 113 : 49;
        constexpr int oWgu = L ? 497 : 129, oG = L ? 177 : 241, oU = L ? 337 : 401, oWd = L ? 537 : 169, oY2 = L ? 177 : 241, oX2 = 49;
        constexpr int oPb = L ? 38 : 593, oWpp = L ? 37 : 197, oPP = L ? 369 : 433, oWpg = L ? 29 : 189, oX2F = L ? 241 : 305;
        if constexpr (L == 0) {
            { EpiRoute e = mkroute(); e.nseg = 4;
              e.seg[0] = mkseg(WSB(113), 8, 2 * 8192, 16 * 8192, 128, 8192);
              e.seg[1] = mkseg(WSB(177), 16, 2 * 8192, 16 * 8192, 128, 8192);
              e.seg[2] = mkseg(WSB(241), 32, 2 * 8192, 32 * 8192, 128, 8192);
              e.seg[3] = mkseg(WSB(369), 48, 256, 64 * 4096, 4096, 128);
              e.halo = WSB(581); e.halo_pn = 32; e.fpn = 48;
              e.ft0.ptr = WSF(577); e.ft0.lc0 = 0; e.ft0.lc1 = 64; e.ft0.ld = 64; e.ft0.scale = 1.f;
              run_gemm(lds, kwid, WSB(49), WSB(0), 12544, 2048, e); }
            GSYNC();
#if MIXER_STAGE >= 1
#ifdef PROBE_G1
            gdn_g1(p, ws, lds, kwid, true);
            __syncthreads();
#endif
            gdn_g1(p, ws, lds, kwid);
            GSYNC();
#ifdef PROBE_G2
            gdn_g2(ws, lds, kwid, true);
            __syncthreads();
#endif
            gdn_g2(ws, lds, kwid);
            GSYNC();
            gdn_g3(p.in[6], WSB(241), WSB(369), kwid);
#else
            zero_fill(WSB(369), (size_t)T * 4096 / 8, kwid);
#endif
            convT_tiles(p.in[7], 4096, 2048, 2048, WSB(113), (LAS float*)lds, tb, kwid);
            convT_tiles(p.in[15], 2048, 5120, 5120, WSB(129), (LAS float*)lds, tb, kwid);
            convT_tiles(p.in[16], 2048, 5120, 5120, WSB(149), (LAS float*)lds, tb, kwid);
            convT_tiles(p.in[18], 5120, 2048, 2048, WSB(169), (LAS float*)lds, tb, kwid);
            convT_tiles(p.in[22], 2048, 2048, 2048, WSB(189), (LAS float*)lds, tb, kwid);
            convT_tiles(p.in[21], 256, 2048, 2048, WSB(197), (LAS float*)lds, tb, kwid);
            cvt_bf16(p.in[1], WSB(593), (size_t)T * 256 / 8, kwid);
            GSYNC();
        } else {
            { EpiRoute e = mkroute(); e.nseg = 4;
              e.seg[0] = mkseg(WSB(49), 8, 256, 64 * 2048, 2048, 128);
              e.seg[1] = mkseg(WSB(177), 10, 256, 64 * 512, 512, 128);
              e.seg[2] = mkseg(WSB(193), 12, 256, 64 * 512, 512, 128);
              e.seg[3] = mkseg(WSB(113), 20, 256, 64 * 2048, 2048, 128);
              e.fpn = 20;
              e.ft0.ptr = WSF(209); e.ft0.lc0 = 0; e.ft0.lc1 = 128; e.ft0.ld = 128; e.ft0.scale = 1.f;
              e.ft1.ptr = WSF(221); e.ft1.lc0 = 128; e.ft1.lc1 = 144; e.ft1.ld = 16; e.ft1.scale = 0.022097086912079608f;
              run_gemm(lds, kwid, WSB(557), WSB(0), 5376, 2048, e); }
            GSYNC();
#if MIXER_STAGE >= 2
            dsa_kiln(WSF(209), p.in[9], p.in[10], WSB(217), kwid);
            GSYNC();
            dsa_phase(WSB(113), WSB(217), WSF(221), WSB(49), WSB(177), WSB(193), WSF(241), p.in[12], lds, kwid);
#else
            zero_fill(WSB(49), (size_t)T * 2048 / 8, kwid);
#endif
            GSYNC();
        }
        { EpiResid f; f.rf = L ? nullptr : p.in[0]; f.rb = L ? WSB(557) : nullptr; f.Y = WSB(oY1);
          run_gemm(lds, kwid, WSB(oA_o), WSB(oWo), 2048, Ko, f); }
        GSYNC();
        ln_phase(WSB(oY1), p.in[13] + L * 2048, p.in[14] + L * 2048, WSB(oX1), nullptr, kwid);
        GSYNC();
        { EpiRoute e = mkroute(); e.nseg = 2;
          e.seg[0] = mkseg(WSB(oG), 20, 256, 64 * 5120, 5120, 128); e.seg[1] = mkseg(WSB(oU), 40, 256, 64 * 5120, 5120, 128);
          run_gemm(lds, kwid, WSB(oX1), WSB(oWgu), 10240, 2048, e); }
        GSYNC();
        convglu_phase(WSB(oG), WSB(oU), p.in[17] + (size_t)L * 3 * 5120, kwid);
        GSYNC();
        { EpiResid f; f.rf = nullptr; f.rb = WSB(oX1); f.Y = WSB(oY2); run_gemm(lds, kwid, WSB(oU), WSB(oWd), 2048, 5120, f); }
        GSYNC();
        ln_phase(WSB(oY2), p.in[19] + L * 2048, p.in[20] + L * 2048, WSB(oX2), WSF(oX2F), kwid);
        if constexpr (L == 0) {
            convT_tiles(p.in[8], 2048, 5264, 5376, WSB(0), (LAS float*)lds, tb, kwid);
            convT_tiles(p.in[11], 2048, 2048, 2048, WSB(21), (LAS float*)lds, tb, kwid);
            convT_tiles(p.in[22] + (size_t)2048 * 2048, 2048, 2048, 2048, WSB(29), (LAS float*)lds, tb, kwid);
            convT_tiles(p.in[21] + (size_t)256 * 2048, 256, 2048, 2048, WSB(37), (LAS float*)lds, tb, kwid);
            cvt_bf16(p.in[1] + (size_t)T * 256, WSB(38), (size_t)T * 256 / 8, kwid);
            convT_tiles(p.in[15] + (size_t)2048 * 5120, 2048, 5120, 5120, WSB(497), (LAS float*)lds, tb, kwid);
            convT_tiles(p.in[16] + (size_t)2048 * 5120, 2048, 5120, 5120, WSB(517), (LAS float*)lds, tb, kwid);
            convT_tiles(p.in[18] + (size_t)5120 * 2048, 5120, 2048, 2048, WSB(537), (LAS float*)lds, tb, kwid);
        }
        __syncthreads();
        { EpiRoute e = mkroute(); e.nseg = 1; e.seg[0] = mkseg(WSB(oPP), 8, 256, 64 * 2048, 2048, 128);
          int Kpp = 256; asm volatile("" : "+s"(Kpp));
          run_gemm(lds, kwid, WSB(oPb), WSB(oWpp), 2048, Kpp, e); }
        GSYNC();
        { EpiPle f; f.x2 = WSF(oX2F); f.PP = WSB(oPP); f.xb = L ? nullptr : WSB(557); f.fo = p.out;
          run_gemm(lds, kwid, WSB(oX2), WSB(oWpg), 2048, 2048, f); }
        GSYNC();
}

__global__ void __launch_bounds__(512, 2) fwd_kernel(KP p) {
    extern __shared__ __attribute__((aligned(16))) unsigned char lds_raw[];
    LAS unsigned char* lds = (LAS unsigned char*)lds_raw;
    cg::grid_group grid = cg::this_grid();
    unsigned char* ws = p.ws;
    int tb = 0;
    int kwid = __builtin_amdgcn_readfirstlane((int)(threadIdx.x >> 6)); asm volatile("" : "+s"(kwid));
    convT_tiles(p.in[2], 2048, 12352, 12544, WSB(0), (LAS float*)lds, tb, kwid);
    cvt_bf16(p.in[0], WSB(49), (size_t)T * 2048 / 8, kwid);
    unsigned* bctr = (unsigned*)(ws + 621 * MiB + 256); unsigned btarget = 0u;
    if (blockIdx.x == 0 && tid_op(kwid) == 0) __hip_atomic_store(bctr, 0u, __ATOMIC_RELAXED, __HIP_MEMORY_SCOPE_AGENT);
    __threadfence(); grid.sync();
    layer_body<0>(p, ws, lds, bctr, btarget, tb, kwid);
    layer_body<1>(p, ws, lds, bctr, btarget, tb, kwid);
}

extern "C" void kernel_launch(void* const* d_in, const int* in_sizes, int n_in, void* d_out, int out_size, void* d_ws, size_t ws_size, hipStream_t stream) {
    static int grid = 0;
    if (grid == 0) {
        if (n_in != 23 || out_size != T * DM || ws_size < 621 * MiB + 4096) { fprintf(stderr, "kernel_launch: unexpected problem (n_in %d, out %d, ws %zu); nothing launched\n", n_in, out_size, ws_size); grid = -1; return; }
        int dev = 0, cus = 0, per_cu = 0;
        hipGetDevice(&dev); hipDeviceGetAttribute(&cus, hipDeviceAttributeMultiprocessorCount, dev);
        if (hipFuncSetAttribute((const void*)fwd_kernel, hipFuncAttributeMaxDynamicSharedMemorySize, LDS_BYTES) != hipSuccess) { fprintf(stderr, "kernel_launch: hipFuncSetAttribute failed\n"); grid = -1; return; }
        if (hipOccupancyMaxActiveBlocksPerMultiprocessor(&per_cu, (const void*)fwd_kernel, 512, LDS_BYTES) != hipSuccess || per_cu < 1) { fprintf(stderr, "kernel_launch: occupancy query says %d\n", per_cu); per_cu = 1; }
        (void)hipGetLastError();
        grid = cus;
        if (grid > 256) grid = 256;
    }
    if (grid < 0) return;
    KP p{};
    for (int i = 0; i < 23; ++i) p.in[i] = (const float*)d_in[i];
    p.out = (float*)d_out; p.ws = (unsigned char*)d_ws;
    void* args[] = {&p};
    hipError_t e = hipLaunchCooperativeKernel((const void*)fwd_kernel, dim3(grid), dim3(512), args, LDS_BYTES, stream);
    if (e != hipSuccess) fprintf(stderr, "cooperative launch failed: %s (grid %d)\n", hipGetErrorString(e), grid);
}
```
